# Optimizing an MI355X kernel written in HIP

```python
import jax, jax.numpy as jnp
from jax import lax
import numpy as np

D_MODEL = 1024
BATCH = 2
SEQ = 8192
DEPTH = 1

GRID_W = 64
CTX_LEN = 256
CONV_WIDTH = D_MODEL // 2
RET_HEADS = 4
RET_HEAD_DIM = (D_MODEL - CONV_WIDTH) // RET_HEADS
RET_WIDTH = RET_HEADS * RET_HEAD_DIM
MIX_WIDTH = CONV_WIDTH + RET_WIDTH
RET_CHUNK = 128
ROPE_BASE = 10000.0
N_EXPERTS = 16
EC_CAPACITY_FACTOR = 2
D_EXPERT = 2 * D_MODEL
RMS_EPS = 1e-6
GN_EPS = 1e-6
SPLITS = (CONV_WIDTH, CONV_WIDTH, CONV_WIDTH, RET_WIDTH, RET_WIDTH, RET_WIDTH, RET_WIDTH)
IN_COLS = sum(SPLITS)
SPLIT_IDX = tuple(int(s) for s in np.cumsum(SPLITS)[:-1])

kernel_name = "hybrid_conv_retention_ec_moe_dit"


def _rms_norm(x, g):
    xf = x.astype(jnp.float32)
    y = xf * lax.rsqrt(jnp.mean(xf * xf, axis=-1, keepdims=True) + RMS_EPS)
    return (y * g.astype(jnp.float32)).astype(x.dtype)


def _modulation(cond, w_ada, b_ada):
    m = jax.nn.silu(cond) @ w_ada + b_ada
    return jnp.split(m[:, None, :], 6, axis=-1)


def _rotary(t, pos):
    half = t.shape[-1] // 2
    inv = 1.0 / (ROPE_BASE ** (jnp.arange(half, dtype=jnp.float32) / half))
    ang = pos[:, None] * inv[None, :]
    cos = jnp.cos(ang)[None, :, None, :]
    sin = jnp.sin(ang)[None, :, None, :]
    t1, t2 = t[..., :half], t[..., half:]
    return jnp.concatenate([t1 * cos - t2 * sin, t1 * sin + t2 * cos], axis=-1)


def _ret_qkv(q, k, v, pos):
    b, n, _ = q.shape
    shp = (b, n, RET_HEADS, RET_HEAD_DIM)
    q = _rotary(q.reshape(shp).astype(jnp.float32), pos)
    k = _rotary(k.reshape(shp).astype(jnp.float32), pos) * (RET_HEAD_DIM ** -0.5)
    v = v.reshape(shp).astype(jnp.float32)
    return q, k, v


def _retention_scan(q, k, v, log_g, s0, include_self):
    b, n, h, d = q.shape
    nc = n // RET_CHUNK
    qc = q.reshape(b, nc, RET_CHUNK, h, d)
    kc = k.reshape(b, nc, RET_CHUNK, h, d)
    vc = v.reshape(b, nc, RET_CHUNK, h, d)
    idx = jnp.arange(RET_CHUNK, dtype=jnp.float32)
    rel = idx[:, None] - idx[None, :]
    mask = (rel >= 0) if include_self else (rel > 0)
    decay = jnp.where(mask[None], jnp.exp(log_g[:, None, None] * jnp.where(mask, rel, 0.0)[None]), 0.0)
    scores = jnp.einsum('bcihd,bcjhd->bchij', qc, kc) * decay[None, None]
    intra = jnp.einsum('bchij,bcjhd->bcihd', scores, vc)
    zeta = jnp.exp(log_g[None, :] * (RET_CHUNK - 1.0 - idx)[:, None])
    u = jnp.einsum('bcjhd,bcjhe->bchde', kc * zeta[None, None, :, :, None], vc)
    g_chunk = jnp.exp(log_g * RET_CHUNK)[None, :, None, None]

    def step(s, u_c):
        return g_chunk * s + u_c, s

    s_final, s_prev = lax.scan(step, s0, jnp.moveaxis(u, 1, 0))
    s_prev = jnp.moveaxis(s_prev, 0, 1)
    xi = jnp.exp(log_g[None, :] * (idx + 1.0)[:, None])
    inter = jnp.einsum('bcihd,bchde->bcihe', qc, s_prev) * xi[None, None, :, :, None]
    return (intra + inter).reshape(b, n, h, d), s_final


def _bidir_retention(q, k, v, log_gf, log_gb, s0_f, s0_b):
    y_f, s_f = _retention_scan(q, k, v, log_gf, s0_f, True)
    flip = lambda t: jnp.flip(t, axis=1)
    y_b, s_b = _retention_scan(flip(q), flip(k), flip(v), log_gb, s0_b, False)
    return y_f + flip(y_b), s_f, s_b


def _context_states(k, v, log_gf, log_gb):
    n = k.shape[1]
    pos = jnp.arange(n, dtype=jnp.float32)
    wf = jnp.exp(log_gf[None, :] * (n - 1.0 - pos)[:, None])
    wb = jnp.exp(log_gb[None, :] * pos[:, None])
    s_f = jnp.einsum('bnhd,nh,bnhe->bhde', k, wf, v)
    s_b = jnp.einsum('bnhd,nh,bnhe->bhde', k, wb, v)
    return s_f, s_b


def _ret_out(y, g, norm_g):
    b, n, _, _ = y.shape
    mu = jnp.mean(y, axis=-1, keepdims=True)
    var = jnp.mean(jnp.square(y - mu), axis=-1, keepdims=True)
    yn = ((y - mu) * lax.rsqrt(var + GN_EPS)).reshape(b, n, RET_WIDTH) * norm_g.astype(jnp.float32)
    return (jax.nn.silu(g.astype(jnp.float32)) * yn).astype(g.dtype)


def _conv_branch(gate_b, gate_c, u_in, w, bias, rows, width):
    bsz, n, ch = u_in.shape
    u = (gate_c * u_in).reshape(bsz, rows, width, ch)
    up = jnp.pad(u, ((0, 0), (0, 0), (1, 1), (0, 0)))
    y = up[:, :, :-2] * w[0] + up[:, :, 1:-1] * w[1] + up[:, :, 2:] * w[2] + bias
    return gate_b * y.reshape(bsz, n, ch)


def _expert_choice_ffn(h, w_router, b_router, w_gate, w_up, w_down):
    b, n, d = h.shape
    cap = max(1, EC_CAPACITY_FACTOR * n // N_EXPERTS)
    logits = h.astype(jnp.float32) @ w_router.astype(jnp.float32) + b_router.astype(jnp.float32)
    aff = jax.nn.softmax(logits, axis=-1)
    gate, idx = lax.top_k(jnp.swapaxes(aff, 1, 2), cap)
    xs = jax.vmap(lambda hb, ib: hb[ib])(h, idx)
    a = jnp.einsum('becd,edf->becf', xs, w_gate)
    u = jnp.einsum('becd,edf->becf', xs, w_up)
    y = jnp.einsum('becf,efd->becd', jax.nn.silu(a) * u, w_down) * gate[..., None].astype(h.dtype)
    return jax.vmap(lambda yb, ib: jnp.zeros((n, d), yb.dtype).at[ib.reshape(-1)].add(yb.reshape(-1, d)))(y, idx)


def setup_inputs(seed: int = 0) -> dict:
    key = jax.random.key(seed)
    ks = jax.random.split(key, 22)
    f32 = jnp.float32

    def nrm(k, shape, scale):
        return jax.random.normal(k, shape, f32) * scale

    decay_base = jnp.log(2.0 ** (5.0 + jnp.arange(RET_HEADS, dtype=f32)) - 1.0)
    return {
        "x": nrm(ks[0], (BATCH, SEQ, D_MODEL), 1.0),
        "c": nrm(ks[1], (BATCH, D_MODEL), 1.0),
        "ctx": nrm(ks[2], (BATCH, CTX_LEN, D_MODEL), 1.0),
        "c_ctx": nrm(ks[3], (D_MODEL,), 1.0),
        "w_ada": nrm(ks[4], (DEPTH, D_MODEL, 6 * D_MODEL), 0.5 * D_MODEL ** -0.5),
        "b_ada": nrm(ks[5], (DEPTH, 6 * D_MODEL), 0.02),
        "pre_mix_g": 1.0 + nrm(ks[6], (DEPTH, D_MODEL), 0.05),
        "post_mix_g": 1.0 + nrm(ks[7], (DEPTH, D_MODEL), 0.05),
        "pre_ffn_g": 1.0 + nrm(ks[8], (DEPTH, D_MODEL), 0.05),
        "post_ffn_g": 1.0 + nrm(ks[9], (DEPTH, D_MODEL), 0.05),
        "w_in": nrm(ks[10], (DEPTH, D_MODEL, IN_COLS), D_MODEL ** -0.5),
        "conv_w": nrm(ks[11], (DEPTH, 3, CONV_WIDTH), 3.0 ** -0.5),
        "conv_b": nrm(ks[12], (DEPTH, CONV_WIDTH), 0.02),
        "ret_decay_logit": decay_base[None, None, :] + nrm(ks[13], (DEPTH, 2, RET_HEADS), 0.1),
        "ret_norm_g": 1.0 + nrm(ks[14], (DEPTH, RET_WIDTH), 0.05),
        "w_out": nrm(ks[15], (DEPTH, MIX_WIDTH, D_MODEL), MIX_WIDTH ** -0.5),
        "w_router": nrm(ks[16], (DEPTH, D_MODEL, N_EXPERTS), D_MODEL ** -0.5),
        "b_router": nrm(ks[17], (DEPTH, N_EXPERTS), 0.01),
        "w_gate": nrm(ks[18], (DEPTH, N_EXPERTS, D_MODEL, D_EXPERT), D_MODEL ** -0.5),
        "w_up": nrm(ks[19], (DEPTH, N_EXPERTS, D_MODEL, D_EXPERT), D_MODEL ** -0.5),
        "w_down": nrm(ks[20], (DEPTH, N_EXPERTS, D_EXPERT, D_MODEL), D_EXPERT ** -0.5),
    }


def reference(x, c, ctx, c_ctx, w_ada, b_ada, pre_mix_g, post_mix_g, pre_ffn_g, post_ffn_g,
              w_in, conv_w, conv_b, ret_decay_logit, ret_norm_g, w_out,
              w_router, b_router, w_gate, w_up, w_down):
    n_lat = x.shape[1]
    ctx_len = ctx.shape[1]
    rows = n_lat // GRID_W
    pos_ctx = jnp.arange(ctx_len, dtype=jnp.float32)
    pos_lat = ctx_len + jnp.arange(n_lat, dtype=jnp.float32)
    bsz = x.shape[0]
    zero_state = jnp.zeros((bsz, RET_HEADS, RET_HEAD_DIM, RET_HEAD_DIM), jnp.float32)

    for i in range(DEPTH):
        last = i == DEPTH - 1
        sh1, sc1, g1, sh2, sc2, g2 = _modulation(c, w_ada[i], b_ada[i])
        csh1, csc1, cg1, csh2, csc2, cg2 = _modulation(c_ctx[None, :], w_ada[i], b_ada[i])
        log_gf = jax.nn.log_sigmoid(ret_decay_logit[i, 0].astype(jnp.float32))
        log_gb = jax.nn.log_sigmoid(ret_decay_logit[i, 1].astype(jnp.float32))

        hc = _rms_norm(ctx, pre_mix_g[i]) * (1.0 + csc1) + csh1
        c_b, c_c, c_x, c_q, c_k, c_v, c_g = jnp.split(hc @ w_in[i], SPLIT_IDX, axis=-1)
        qc, kc, vc = _ret_qkv(c_q, c_k, c_v, pos_ctx)
        if last:
            s_f, s_b = _context_states(kc, vc, log_gf, log_gb)
            ctx_next = ctx
        else:
            yc, s_f, s_b = _bidir_retention(qc, kc, vc, log_gf, log_gb, zero_state, zero_state)
            mix_c = jnp.concatenate([
                _conv_branch(c_b, c_c, c_x, conv_w[i], conv_b[i], 1, ctx_len),
                _ret_out(yc, c_g, ret_norm_g[i])], axis=-1) @ w_out[i]
            ctx_mid = ctx + cg1 * _rms_norm(mix_c, post_mix_g[i])
            hc2 = _rms_norm(ctx_mid, pre_ffn_g[i]) * (1.0 + csc2) + csh2
            ffn_c = _expert_choice_ffn(hc2, w_router[i], b_router[i], w_gate[i], w_up[i], w_down[i])
            ctx_next = ctx_mid + cg2 * _rms_norm(ffn_c, post_ffn_g[i])

        hx = _rms_norm(x, pre_mix_g[i]) * (1.0 + sc1) + sh1
        x_b, x_c, x_x, x_q, x_k, x_v, x_g = jnp.split(hx @ w_in[i], SPLIT_IDX, axis=-1)
        qx, kx, vx = _ret_qkv(x_q, x_k, x_v, pos_lat)
        yx, _, _ = _bidir_retention(qx, kx, vx, log_gf, log_gb, s_f, s_b)
        mix_x = jnp.concatenate([
            _conv_branch(x_b, x_c, x_x, conv_w[i], conv_b[i], rows, GRID_W),
            _ret_out(yx, x_g, ret_norm_g[i])], axis=-1) @ w_out[i]
        x = x + g1 * _rms_norm(mix_x, post_mix_g[i])
        hx2 = _rms_norm(x, pre_ffn_g[i]) * (1.0 + sc2) + sh2
        ffn_x = _expert_choice_ffn(hx2, w_router[i], b_router[i], w_gate[i], w_up[i], w_down[i])
        x = x + g2 * _rms_norm(ffn_x, post_ffn_g[i])
        ctx = ctx_next
    return x
```

```cpp
#include <hip/hip_runtime.h>
#include <cstdint>
#include <cstdio>

typedef _Float16 half_t;
typedef _Float16 half8 __attribute__((ext_vector_type(8)));
typedef _Float16 half4 __attribute__((ext_vector_type(4)));
typedef float f32x4 __attribute__((ext_vector_type(4)));

constexpr int D = 1024, NB = 2, SEQ = 8192, M = NB * SEQ, CTXL = 256, MC = NB * CTXL, MR = M + MC;
constexpr int CW = 512, NH = 4, HD = 128, RW = 512, INC = 3584;
constexpr int NCHK = 66;
constexpr int NE = 16, CAP = 1024, DE = 2048;
constexpr float RMS_EPS = 1e-6f, GN_EPS = 1e-6f;

constexpr size_t MiB = 1u << 20;
constexpr size_t WS_CTL = 0;
constexpr size_t WS_MODP = 1 * MiB;
constexpr size_t WS_MOD = 3 * MiB;
constexpr size_t WS_ROPE = 4 * MiB;
constexpr size_t WS_ROPE_SIN = WS_ROPE + 2560 * 1024;
constexpr size_t WS_AFF = 9 * MiB;
constexpr size_t WS_IDX = 10 * MiB;
constexpr size_t WS_GATE = WS_IDX + 256 * 1024;
constexpr size_t WS_INV = 11 * MiB;
constexpr size_t WS_WIN = 12 * MiB;
constexpr size_t WS_WOUT = 19 * MiB;
constexpr size_t WS_WGU = 21 * MiB;
constexpr size_t WS_WD = 149 * MiB;
constexpr size_t WS_A = 213 * MiB;
constexpr size_t WS_HX = WS_A, WS_MIXA = WS_A + 33 * MiB, WS_HX2 = WS_A, WS_Y = WS_A;
constexpr size_t WS_B = 279 * MiB;
constexpr size_t WS_XB = WS_B, WS_XC = WS_B + 16 * MiB, WS_XX = WS_B + 32 * MiB, WS_G = WS_B + 48 * MiB;
constexpr size_t WS_Q = WS_B + 64 * MiB, WS_K = WS_Q + 17 * MiB, WS_V = WS_K + 17 * MiB;
constexpr size_t WS_US = WS_V + 17 * MiB;
constexpr size_t WS_H = WS_B;
constexpr size_t WS_END = WS_US + 66 * MiB;
static_assert(WS_H + 128 * MiB <= WS_END, "H overlay");

struct P {
    const float *x, *c, *ctx, *c_ctx, *w_ada, *b_ada, *pre_mix_g, *post_mix_g, *pre_ffn_g, *post_ffn_g, *w_in, *conv_w, *conv_b, *decay, *ret_norm_g, *w_out,
        *w_router, *b_router, *w_gate, *w_up, *w_down;
    float* out; unsigned char* ws;
};

__device__ __forceinline__ float wave_sum(float v) {
#pragma unroll
    for (int o = 1; o < 64; o <<= 1) v += __shfl_xor(v, o);
    return v;
}
__device__ __forceinline__ float silu_f(float v) { return v / (1.0f + expf(-v)); }
__device__ __forceinline__ float log_sigmoid_f(float v) { return v >= 0.f ? -log1pf(expf(-v)) : v - log1pf(expf(v)); }

__host__ __device__ __forceinline__ int in_col_src(int R) {
    if (R < 1536 || R >= 2560) return R;
    const int base = R & ~127, w = R & 127, span = w >> 6, blk = (w & 63) >> 4, i = w & 15;
    return base + span * 32 + (blk >> 1) * 16 + i + (blk & 1) * 64;
}
constexpr int GU_G = 32;

__device__ void ph_mod_partial(const P& p, int wg, int nwg) {
    const int sub = threadIdx.x >> 8, nsub = blockDim.x >> 8, t = threadIdx.x & 255;
    float* part = (float*)(p.ws + WS_MODP);
    for (int it = wg * nsub + sub; it < 24 * 16; it += nwg * nsub) {
        const int cb = it % 24, ks = it / 24, col = cb * 256 + t;
        float a0 = 0.f, a1 = 0.f, a2 = 0.f;
        for (int k = ks * 64; k < ks * 64 + 64; ++k) {
            const float w = p.w_ada[(size_t)k * 6144 + col];
            a0 += silu_f(p.c[k]) * w; a1 += silu_f(p.c[1024 + k]) * w; a2 += silu_f(p.c_ctx[k]) * w;
        }
        part[(ks * 3 + 0) * 6144 + col] = a0; part[(ks * 3 + 1) * 6144 + col] = a1; part[(ks * 3 + 2) * 6144 + col] = a2;
    }
}
__device__ void ph_mod_reduce(const P& p, int wg, int nwg) {
    const float* part = (const float*)(p.ws + WS_MODP); float* mod = (float*)(p.ws + WS_MOD);
    for (int i = wg * blockDim.x + threadIdx.x; i < 3 * 6144; i += nwg * blockDim.x) {
        const int col = i % 6144; float s = p.b_ada[col];
        for (int ks = 0; ks < 16; ++ks) s += part[ks * 3 * 6144 + i];
        mod[i] = s;
    }
}
__device__ void ph_rope(const P& p, int wg, int nwg) {
    float* ct = (float*)(p.ws + WS_ROPE); float* st = (float*)(p.ws + WS_ROPE_SIN);
    for (int i = wg * blockDim.x + threadIdx.x; i < 8448 * 64; i += nwg * blockDim.x) {
        const int pos = i >> 6, j = i & 63;
        const float inv = 1.0f / powf(10000.0f, (float)j / 64.0f);
        const float ang = (float)pos * inv;
        const double a = (double)ang; const double kk = rint(a * 0.15915494309189535); const double r = a - kk * 6.283185307179586476925;
        ct[i] = (float)cos(r); st[i] = (float)sin(r);
    }
}
template <class Map>
__device__ __forceinline__ void transpose_item(const float* W, int K, int N, half_t* WT, float* scr, int item, int lane, Map srcmap) {
    const int nblk = N / 32, kb = item / nblk, nb = item % nblk, k0 = 64 * kb, n0 = 32 * nb;
    const int scol = srcmap(n0 + (lane & 31));
#pragma unroll 8
    for (int i = 0; i < 32; ++i) { const int kk = 2 * i + (lane >> 5); scr[kk * 33 + (lane & 31)] = W[(size_t)(k0 + kk) * N + scol]; }
    __builtin_amdgcn_s_waitcnt(0xc07f); asm volatile("" ::: "memory");
    const int c = lane & 7;
#pragma unroll
    for (int j = 0; j < 4; ++j) { const int n = (lane >> 3) + 8 * j; const float* s = scr + (8 * c) * 33 + n;
        half8 o;
#pragma unroll
        for (int q = 0; q < 8; ++q) o[q] = (half_t)s[q * 33];
        *(half8*)(WT + (size_t)(n0 + n) * K + k0 + 8 * c) = o; }
    __builtin_amdgcn_s_waitcnt(0xc07f); asm volatile("" ::: "memory");
}
struct MapId { __device__ int operator()(int R) const { return R; } };
struct MapIn { __device__ int operator()(int R) const { return in_col_src(R); } };
__device__ void ph_prep_weights(const P& p, int wg, int nwg, float* lds_f) {
    const int lane = threadIdx.x & 63, wv = threadIdx.x >> 6, nwv = blockDim.x >> 6;
    float* scr = lds_f + wv * (64 * 33);
    half_t* Win = (half_t*)(p.ws + WS_WIN); half_t* Wout = (half_t*)(p.ws + WS_WOUT); half_t* Wgu = (half_t*)(p.ws + WS_WGU); half_t* Wd = (half_t*)(p.ws + WS_WD);
    constexpr int I_IN = (D / 64) * (INC / 32), I_OUT = (D / 64) * (D / 32), I_G = (D / 64) * (DE / 32), I_D = (DE / 64) * (D / 32);
    constexpr int NIT = I_IN + I_OUT + NE * (2 * I_G + I_D);
    for (int it = wg * nwv + wv; it < NIT; it += nwg * nwv) {
        int r = it;
        if (r < I_IN) { transpose_item(p.w_in, D, INC, Win, scr, r, lane, MapIn()); continue; } r -= I_IN;
        if (r < I_OUT) { transpose_item(p.w_out, D, D, Wout, scr, r, lane, MapId()); continue; } r -= I_OUT;
        const int e = r / (2 * I_G + I_D); r -= e * (2 * I_G + I_D);
        if (r < 2 * I_G) {
            const int which = r / I_G, item = r % I_G;
            const float* W = (which ? p.w_up : p.w_gate) + (size_t)e * D * DE;
            const int nblk = DE / 32, kb = item / nblk, nb = item % nblk, k0 = 64 * kb, n0 = 32 * nb;
            half_t* WT = Wgu + (size_t)e * 4096 * D;
#pragma unroll 8
            for (int i = 0; i < 32; ++i) { const int kk = 2 * i + (lane >> 5); scr[kk * 33 + (lane & 31)] = W[(size_t)(k0 + kk) * DE + n0 + (lane & 31)]; }
            __builtin_amdgcn_s_waitcnt(0xc07f); asm volatile("" ::: "memory");
            const int c = lane & 7;
#pragma unroll
            for (int j = 0; j < 4; ++j) { const int n = (lane >> 3) + 8 * j; const float* s = scr + (8 * c) * 33 + n;
                half8 o;
#pragma unroll
                for (int q = 0; q < 8; ++q) o[q] = (half_t)s[q * 33];
                *(half8*)(WT + (size_t)(nb * 64 + which * 32 + n) * D + k0 + 8 * c) = o; }
            __builtin_amdgcn_s_waitcnt(0xc07f); asm volatile("" ::: "memory");
            continue;
        }
        r -= 2 * I_G;
        transpose_item(p.w_down + (size_t)e * DE * D, DE, D, Wd + (size_t)e * D * DE, scr, r, lane, MapId());
    }
}
__device__ void ph_hx(const P& p, int wg, int nwg) {
    const int lane = threadIdx.x & 63, wv = threadIdx.x >> 6, nwv = blockDim.x >> 6;
    const float* mod = (const float*)(p.ws + WS_MOD); half_t* HX = (half_t*)(p.ws + WS_HX);
    for (int row = wg * nwv + wv; row < MR; row += nwg * nwv) {
        const float* src; int mr;
        if (row < M) { src = p.x + (size_t)row * D; mr = row / SEQ; } else { src = p.ctx + (size_t)(row - M) * D; mr = 2; }
        const float* sh = mod + mr * 6144; const float* sc = sh + 1024;
        f32x4 v[4]; float ss = 0.f;
#pragma unroll
        for (int j = 0; j < 4; ++j) { v[j] = ((const f32x4*)src)[lane + 64 * j]; ss += (v[j][0] * v[j][0] + v[j][1] * v[j][1]) + (v[j][2] * v[j][2] + v[j][3] * v[j][3]); }
        ss = wave_sum(ss); const float rstd = 1.0f / sqrtf(ss * (1.0f / D) + RMS_EPS);
#pragma unroll
        for (int j = 0; j < 4; ++j) { const int i0 = 4 * lane + 256 * j;
            const f32x4 g = *(const f32x4*)(p.pre_mix_g + i0), s = *(const f32x4*)(sc + i0), h = *(const f32x4*)(sh + i0);
            half4 o;
#pragma unroll
            for (int q = 0; q < 4; ++q) o[q] = (half_t)(v[j][q] * rstd * g[q] * (1.0f + s[q]) + h[q]);
            *(half4*)(HX + (size_t)row * D + i0) = o; }
    }
}
struct TileInfo { const half_t* Bt; int K; int g, tm, tn; };
template <class G>
__global__ __launch_bounds__(256) void k_gemm128(G g, P p) {
    extern __shared__ __attribute__((aligned(16))) unsigned char smem[];
    half_t* SA = (half_t*)smem; half_t* SB = SA + 128 * 32;
    const TileInfo T = g.tile(p, blockIdx.x);
    const int tid = threadIdx.x, wid = tid >> 6, lane = tid & 63, wr = wid >> 1, wc = wid & 1, fr = lane & 15, fq = lane >> 4;
    const half_t* arow[2]; const half_t* brow[2];
#pragma unroll
    for (int i = 0; i < 2; ++i) { const int b = tid * 16 + i * 4096, r = b / 64, c = (b % 64) / 2; arow[i] = g.a_row(p, T, r) + c; brow[i] = T.Bt + (size_t)(T.tn * 128 + r) * T.K + c; }
    f32x4 acc[4][4];
#pragma unroll
    for (int m = 0; m < 4; ++m)
#pragma unroll
        for (int n = 0; n < 4; ++n) acc[m][n] = (f32x4){0.f, 0.f, 0.f, 0.f};
    for (int t = 0; t < T.K / 32; ++t) {
#pragma unroll
        for (int i = 0; i < 2; ++i) { const int b = tid * 16 + i * 4096;
            __builtin_amdgcn_global_load_lds((const unsigned*)(arow[i] + t * 32), (unsigned*)((char*)SA + b), 16, 0, 0);
            __builtin_amdgcn_global_load_lds((const unsigned*)(brow[i] + t * 32), (unsigned*)((char*)SB + b), 16, 0, 0); }
        asm volatile("s_waitcnt vmcnt(0)" ::: "memory"); __syncthreads();
        half8 At[4], Bl[4];
#pragma unroll
        for (int m = 0; m < 4; ++m) { At[m] = *(const half8*)((const char*)SA + (wr * 64 + m * 16 + fr) * 64 + fq * 16); Bl[m] = *(const half8*)((const char*)SB + (wc * 64 + m * 16 + fr) * 64 + fq * 16); }
#pragma unroll
        for (int m = 0; m < 4; ++m)
#pragma unroll
            for (int n = 0; n < 4; ++n) acc[m][n] = __builtin_amdgcn_mfma_f32_16x16x32_f16(At[m], Bl[n], acc[m][n], 0, 0, 0);
        __syncthreads();
    }
    g.epi(p, T, acc, wr, wc, fr, fq);
}
struct GemmIn {
    __device__ TileInfo tile(const P& p, int t) const { TileInfo T; T.Bt = (const half_t*)(p.ws + WS_WIN); T.K = D; T.g = 0; T.tm = t / 28; T.tn = t % 28; return T; }
    __device__ const half_t* a_row(const P& p, const TileInfo& T, int r) const { return (const half_t*)(p.ws + WS_HX) + (size_t)(T.tm * 128 + r) * D; }
    __device__ void epi(const P& p, const TileInfo& T, f32x4 (&acc)[4][4], int wr, int wc, int fr, int fq) const {
        const int col0 = T.tn * 128 + wc * 64, sec = col0 / 512, within = col0 % 512;
        const float* ct = (const float*)(p.ws + WS_ROPE); const float* st = (const float*)(p.ws + WS_ROPE_SIN);
#pragma unroll
        for (int m = 0; m < 4; ++m)
#pragma unroll
            for (int j = 0; j < 4; ++j) {
                const int row = T.tm * 128 + wr * 64 + m * 16 + fq * 4 + j;
                if (sec == 3 || sec == 4) {
                    const int hh = within / 128, span = (within % 128) / 64;
                    const int pos = row < M ? CTXL + (row % SEQ) : (row - M) % CTXL;
                    half_t* dst = (half_t*)(p.ws + (sec == 3 ? WS_Q : WS_K)) + (size_t)row * RW + hh * 128;
                    const float scl = sec == 4 ? 0.08838834764831845f : 1.0f;
#pragma unroll
                    for (int n = 0; n < 4; n += 2) {
                        const int d1 = span * 32 + (n >> 1) * 16 + fr;
                        const float cs = ct[pos * 64 + d1], sn = st[pos * 64 + d1];
                        const float t1 = acc[m][n][j], t2 = acc[m][n + 1][j];
                        dst[d1] = (half_t)((t1 * cs - t2 * sn) * scl); dst[d1 + 64] = (half_t)((t1 * sn + t2 * cs) * scl);
                    }
                } else if (sec == 5) {
                    half_t* dst = (half_t*)(p.ws + WS_V) + (size_t)row * RW + within;
#pragma unroll
                    for (int n = 0; n < 4; ++n) dst[n * 16 + fr] = (half_t)acc[m][n][j];
                } else if (row < M) {
                    const size_t off = sec == 0 ? WS_XB : sec == 1 ? WS_XC : sec == 2 ? WS_XX : WS_G;
                    half_t* dst = (half_t*)(p.ws + off) + (size_t)row * CW + within;
#pragma unroll
                    for (int n = 0; n < 4; ++n) dst[n * 16 + fr] = (half_t)acc[m][n][j];
                }
            }
    }
};
struct GemmOut {
    __device__ TileInfo tile(const P& p, int t) const { TileInfo T; T.Bt = (const half_t*)(p.ws + WS_WOUT); T.K = D; T.g = 0; T.tm = t / 8; T.tn = t % 8; return T; }
    __device__ const half_t* a_row(const P& p, const TileInfo& T, int r) const { return (const half_t*)(p.ws + WS_MIXA) + (size_t)(T.tm * 128 + r) * D; }
    __device__ void epi(const P& p, const TileInfo& T, f32x4 (&acc)[4][4], int wr, int wc, int fr, int fq) const {
#pragma unroll
        for (int m = 0; m < 4; ++m)
#pragma unroll
            for (int j = 0; j < 4; ++j) { float* dst = p.out + (size_t)(T.tm * 128 + wr * 64 + m * 16 + fq * 4 + j) * D + T.tn * 128 + wc * 64;
#pragma unroll
                for (int n = 0; n < 4; ++n) dst[n * 16 + fr] = acc[m][n][j]; }
    }
};
struct GemmGU {
    __device__ TileInfo tile(const P& p, int t) const { TileInfo T; T.g = t / 256; const int r = t % 256; T.tm = r / 32; T.tn = r % 32; T.K = D;
        T.Bt = (const half_t*)(p.ws + WS_WGU) + (size_t)(T.g % NE) * 4096 * D; return T; }
    __device__ const half_t* a_row(const P& p, const TileInfo& T, int r) const {
        const int tok = ((const int*)(p.ws + WS_IDX))[T.g * CAP + T.tm * 128 + r]; return (const half_t*)(p.ws + WS_HX2) + (size_t)((T.g / NE) * SEQ + tok) * D; }
    __device__ void epi(const P& p, const TileInfo& T, f32x4 (&acc)[4][4], int wr, int wc, int fr, int fq) const {
        const int chunk = T.tn * 2 + wc;
        half_t* Hb = (half_t*)(p.ws + WS_H) + (size_t)T.g * CAP * DE;
#pragma unroll
        for (int m = 0; m < 4; ++m)
#pragma unroll
            for (int j = 0; j < 4; ++j) { half_t* dst = Hb + (size_t)(T.tm * 128 + wr * 64 + m * 16 + fq * 4 + j) * DE + chunk * 32;
#pragma unroll
                for (int n = 0; n < 2; ++n) { const float a = acc[m][n][j], u = acc[m][n + 2][j]; dst[n * 16 + fr] = (half_t)(silu_f(a) * u); } }
    }
};
struct GemmDown {
    __device__ TileInfo tile(const P& p, int t) const { TileInfo T; T.g = t / 64; const int r = t % 64; T.tm = r / 8; T.tn = r % 8; T.K = DE;
        T.Bt = (const half_t*)(p.ws + WS_WD) + (size_t)(T.g % NE) * D * DE; return T; }
    __device__ const half_t* a_row(const P& p, const TileInfo& T, int r) const { return (const half_t*)(p.ws + WS_H) + (size_t)(T.g * CAP + T.tm * 128 + r) * DE; }
    __device__ void epi(const P& p, const TileInfo& T, f32x4 (&acc)[4][4], int wr, int wc, int fr, int fq) const {
        const float* gate = (const float*)(p.ws + WS_GATE) + T.g * CAP;
        half_t* Yb = (half_t*)(p.ws + WS_Y) + (size_t)T.g * CAP * D;
#pragma unroll
        for (int m = 0; m < 4; ++m)
#pragma unroll
            for (int j = 0; j < 4; ++j) { const int slot = T.tm * 128 + wr * 64 + m * 16 + fq * 4 + j; const float gt = gate[slot];
                half_t* dst = Yb + (size_t)slot * D + T.tn * 128 + wc * 64;
#pragma unroll
                for (int n = 0; n < 4; ++n) dst[n * 16 + fr] = (half_t)(acc[m][n][j] * gt); }
    }
};
__device__ __forceinline__ int chunk_row0(int b, int ch) { return ch < 2 ? M + b * CTXL + ch * 128 : b * SEQ + (ch - 2) * 128; }
__device__ void ph_r1(const P& p, int wg, int nwg, float* lds) {
    float* ks = lds; float* vs = lds + 128 * 128; float* wts = lds + 2 * 128 * 128;
    const half_t* Kb = (const half_t*)(p.ws + WS_K); const half_t* Vb = (const half_t*)(p.ws + WS_V); float* US = (float*)(p.ws + WS_US);
    const int tid = threadIdx.x, nthr = blockDim.x;
    for (int it = wg; it < 8 * NCHK; it += nwg) {
        const int bh = it / NCHK, ch = it % NCHK, b = bh >> 2, h = bh & 3, row0 = chunk_row0(b, ch);
        __syncthreads();
        for (int i = tid; i < 128 * 16; i += nthr) { const int j = i >> 4, c8 = (i & 15) * 8;
            const half8 kv = *(const half8*)(Kb + (size_t)(row0 + j) * RW + h * 128 + c8), vv = *(const half8*)(Vb + (size_t)(row0 + j) * RW + h * 128 + c8);
#pragma unroll
            for (int q = 0; q < 8; ++q) { ks[j * 128 + c8 + q] = (float)kv[q]; vs[j * 128 + c8 + q] = (float)vv[q]; } }
        if (tid < 256) { const int dir = tid >> 7, j = tid & 127; const float lg = log_sigmoid_f(p.decay[dir * 4 + h]); wts[tid] = expf(lg * (dir == 0 ? (float)(127 - j) : (float)j)); }
        __syncthreads();
        for (int mt = tid; mt < 512; mt += nthr) {
            const int dir = mt >> 8, d0 = ((mt & 255) >> 4) * 8, e0 = (mt & 15) * 8;
            float acc[8][8];
#pragma unroll
            for (int x = 0; x < 8; ++x)
#pragma unroll
                for (int y = 0; y < 8; ++y) acc[x][y] = 0.f;
            for (int j = 0; j < 128; ++j) {
                const float w = wts[dir * 128 + j];
                const f32x4 a0 = *(const f32x4*)(ks + j * 128 + d0), a1 = *(const f32x4*)(ks + j * 128 + d0 + 4), b0 = *(const f32x4*)(vs + j * 128 + e0), b1 = *(const f32x4*)(vs + j * 128 + e0 + 4);
                float a[8] = {a0[0] * w, a0[1] * w, a0[2] * w, a0[3] * w, a1[0] * w, a1[1] * w, a1[2] * w, a1[3] * w};
                float bb[8] = {b0[0], b0[1], b0[2], b0[3], b1[0], b1[1], b1[2], b1[3]};
#pragma unroll
                for (int x = 0; x < 8; ++x)
#pragma unroll
                    for (int y = 0; y < 8; ++y) acc[x][y] += a[x] * bb[y];
            }
            float* dst = US + ((size_t)(bh * NCHK + ch) * 2 + dir) * 16384;
#pragma unroll
            for (int x = 0; x < 8; ++x) { *(f32x4*)(dst + (d0 + x) * 128 + e0) = (f32x4){acc[x][0], acc[x][1], acc[x][2], acc[x][3]}; *(f32x4*)(dst + (d0 + x) * 128 + e0 + 4) = (f32x4){acc[x][4], acc[x][5], acc[x][6], acc[x][7]}; }
        }
    }
}
__device__ void ph_scan(const P& p, int wg, int nwg) {
    float* US = (float*)(p.ws + WS_US);
    for (int i = wg * blockDim.x + threadIdx.x; i < 8 * 2 * 16384; i += nwg * blockDim.x) {
        const int el = i & 16383, dir = (i >> 14) & 1, bh = i >> 15, h = bh & 3;
        const float g128 = expf(log_sigmoid_f(p.decay[dir * 4 + h]) * 128.0f);
        float S = 0.f;
        for (int s = 0; s < NCHK; ++s) {
            const int ch = dir == 0 ? s : (s == 0 ? 1 : (s == 1 ? 0 : 67 - s));
            float* ptr = US + ((size_t)(bh * NCHK + ch) * 2 + dir) * 16384 + el;
            const float u = *ptr; *ptr = S; S = g128 * S + u;
        }
    }
}
__device__ void ph_r3(const P& p, int wg, int nwg, float* lds) {
    float* A = lds; float* qT = A + 128 * 132; float* Pm = qT + 128 * 68; float* stats = Pm + 64 * 132; float* dt = stats + 128;
    const half_t* Qb = (const half_t*)(p.ws + WS_Q); const half_t* Kb = (const half_t*)(p.ws + WS_K); const half_t* Vb = (const half_t*)(p.ws + WS_V); const half_t* Gb = (const half_t*)(p.ws + WS_G);
    const float* US = (const float*)(p.ws + WS_US); half_t* MIXA = (half_t*)(p.ws + WS_MIXA);
    const int tid = threadIdx.x, nthr = blockDim.x;
    for (int it = wg; it < 8 * 64; it += nwg) {
        const int bh = it / 64, c = it % 64, b = bh >> 2, h = bh & 3, row0 = b * SEQ + c * 128, ch = c + 2;
        const float lgf = log_sigmoid_f(p.decay[h]), lgb = log_sigmoid_f(p.decay[4 + h]);
        const float* Sf = US + ((size_t)(bh * NCHK + ch) * 2 + 0) * 16384; const float* Sb = Sf + 16384;
        __syncthreads();
        if (tid < 128) { dt[tid] = expf(lgf * (float)tid); dt[128 + tid] = expf(lgb * (float)tid); dt[256 + tid] = expf(lgf * (float)(tid + 1)); dt[384 + tid] = expf(lgb * (float)(128 - tid)); }
        for (int half = 0; half < 2; ++half) {
            __syncthreads();
            for (int i = tid; i < 128 * 16; i += nthr) { const int j = i >> 4, c8 = (i & 15) * 8; const half8 kv = *(const half8*)(Kb + (size_t)(row0 + j) * RW + h * 128 + c8);
#pragma unroll
                for (int q = 0; q < 8; ++q) A[(c8 + q) * 132 + j] = (float)kv[q]; }
            for (int i = tid; i < 64 * 16; i += nthr) { const int j = i >> 4, c8 = (i & 15) * 8; const half8 qv = *(const half8*)(Qb + (size_t)(row0 + half * 64 + j) * RW + h * 128 + c8);
#pragma unroll
                for (int q = 0; q < 8; ++q) qT[(c8 + q) * 68 + j] = (float)qv[q]; }
            __syncthreads();
            for (int mt = tid; mt < 256; mt += nthr) {
                const int i0 = (mt >> 4) * 4, j0 = (mt & 15) * 8;
                float acc[4][8];
#pragma unroll
                for (int x = 0; x < 4; ++x)
#pragma unroll
                    for (int y = 0; y < 8; ++y) acc[x][y] = 0.f;
                for (int d = 0; d < 128; ++d) {
                    const f32x4 a = *(const f32x4*)(qT + d * 68 + i0), b0 = *(const f32x4*)(A + d * 132 + j0), b1 = *(const f32x4*)(A + d * 132 + j0 + 4);
                    const float bb[8] = {b0[0], b0[1], b0[2], b0[3], b1[0], b1[1], b1[2], b1[3]};
#pragma unroll
                    for (int x = 0; x < 4; ++x)
#pragma unroll
                        for (int y = 0; y < 8; ++y) acc[x][y] += a[x] * bb[y];
                }
#pragma unroll
                for (int x = 0; x < 4; ++x)
#pragma unroll
                    for (int y = 0; y < 8; ++y) { const int i = half * 64 + i0 + x, j = j0 + y; const float dd = i >= j ? dt[i - j] : dt[128 + j - i]; Pm[(i0 + x) * 132 + j] = acc[x][y] * dd; }
            }
            __syncthreads();
            for (int i = tid; i < 128 * 16; i += nthr) { const int j = i >> 4, c8 = (i & 15) * 8; const half8 vv = *(const half8*)(Vb + (size_t)(row0 + j) * RW + h * 128 + c8);
#pragma unroll
                for (int q = 0; q < 8; ++q) A[j * 132 + c8 + q] = (float)vv[q]; }
            __syncthreads();
            float yacc[4][8]; int yi0 = 0, ye0 = 0; const bool active = tid < 256;
            if (active) {
                const int mt = tid; yi0 = (mt >> 4) * 4; ye0 = (mt & 15) * 8;
#pragma unroll
                for (int x = 0; x < 4; ++x)
#pragma unroll
                    for (int y = 0; y < 8; ++y) yacc[x][y] = 0.f;
                for (int j = 0; j < 128; ++j) {
                    const f32x4 b0 = *(const f32x4*)(A + j * 132 + ye0), b1 = *(const f32x4*)(A + j * 132 + ye0 + 4);
                    const float bb[8] = {b0[0], b0[1], b0[2], b0[3], b1[0], b1[1], b1[2], b1[3]};
#pragma unroll
                    for (int x = 0; x < 4; ++x) { const float a = Pm[(yi0 + x) * 132 + j];
#pragma unroll
                        for (int y = 0; y < 8; ++y) yacc[x][y] += a * bb[y]; }
                }
                float xf[4], xb[4];
#pragma unroll
                for (int x = 0; x < 4; ++x) { xf[x] = dt[256 + half * 64 + yi0 + x]; xb[x] = dt[384 + half * 64 + yi0 + x]; }
                for (int d = 0; d < 128; ++d) {
                    const f32x4 q4 = *(const f32x4*)(qT + d * 68 + yi0);
                    const f32x4 f0 = *(const f32x4*)(Sf + d * 128 + ye0), f1 = *(const f32x4*)(Sf + d * 128 + ye0 + 4), g0 = *(const f32x4*)(Sb + d * 128 + ye0), g1 = *(const f32x4*)(Sb + d * 128 + ye0 + 4);
                    const float ff[8] = {f0[0], f0[1], f0[2], f0[3], f1[0], f1[1], f1[2], f1[3]}; const float gg[8] = {g0[0], g0[1], g0[2], g0[3], g1[0], g1[1], g1[2], g1[3]};
#pragma unroll
                    for (int x = 0; x < 4; ++x) { const float qf = q4[x] * xf[x], qb = q4[x] * xb[x];
#pragma unroll
                        for (int y = 0; y < 8; ++y) yacc[x][y] += qf * ff[y] + qb * gg[y]; }
                }
            }
            __syncthreads();
            if (active) {
#pragma unroll
                for (int x = 0; x < 4; ++x)
#pragma unroll
                    for (int y = 0; y < 8; ++y) Pm[(yi0 + x) * 132 + ye0 + y] = yacc[x][y];
            }
            __syncthreads();
            if (tid < 64) { float s = 0.f; for (int e = 0; e < 128; ++e) s += Pm[tid * 132 + e]; const float mu = s * (1.0f / 128.0f); float q = 0.f;
                for (int e = 0; e < 128; ++e) { const float dlt = Pm[tid * 132 + e] - mu; q += dlt * dlt; }
                stats[tid * 2] = mu; stats[tid * 2 + 1] = 1.0f / sqrtf(q * (1.0f / 128.0f) + GN_EPS); }
            __syncthreads();
            for (int i = tid; i < 64 * 128; i += nthr) { const int r = i >> 7, e = i & 127, row = row0 + half * 64 + r;
                const float yn = (Pm[r * 132 + e] - stats[r * 2]) * stats[r * 2 + 1] * p.ret_norm_g[h * 128 + e];
                const float gv = (float)Gb[(size_t)row * CW + h * 128 + e];
                MIXA[(size_t)row * D + CW + h * 128 + e] = (half_t)(silu_f(gv) * yn); }
        }
    }
}
__device__ void ph_conv(const P& p, int wg, int nwg) {
    const half_t* XB = (const half_t*)(p.ws + WS_XB); const half_t* XC = (const half_t*)(p.ws + WS_XC); const half_t* XX = (const half_t*)(p.ws + WS_XX); half_t* MIXA = (half_t*)(p.ws + WS_MIXA);
    for (int i = wg * blockDim.x + threadIdx.x; i < M * 64; i += nwg * blockDim.x) {
        const int row = i >> 6, ch0 = (i & 63) * 8, n = row & 63;
        const size_t o = (size_t)row * CW + ch0;
        const half8 c1 = *(const half8*)(XC + o), x1 = *(const half8*)(XX + o), bb = *(const half8*)(XB + o);
        half8 c0 = c1, x0 = x1, c2 = c1, x2 = x1;
        if (n != 0) { c0 = *(const half8*)(XC + o - CW); x0 = *(const half8*)(XX + o - CW); }
        if (n != 63) { c2 = *(const half8*)(XC + o + CW); x2 = *(const half8*)(XX + o + CW); }
        half8 r;
#pragma unroll
        for (int q = 0; q < 8; ++q) {
            const float up = n != 0 ? (float)c0[q] * (float)x0[q] : 0.f, u = (float)c1[q] * (float)x1[q], un = n != 63 ? (float)c2[q] * (float)x2[q] : 0.f;
            const float y = up * p.conv_w[ch0 + q] + u * p.conv_w[CW + ch0 + q] + un * p.conv_w[2 * CW + ch0 + q] + p.conv_b[ch0 + q];
            r[q] = (half_t)((float)bb[q] * y);
        }
        *(half8*)(MIXA + (size_t)row * D + ch0) = r;
    }
}
__device__ void ph_postmix(const P& p, int wg, int nwg) {
    const int lane = threadIdx.x & 63, wv = threadIdx.x >> 6, nwv = blockDim.x >> 6;
    const float* mod = (const float*)(p.ws + WS_MOD); half_t* HX2 = (half_t*)(p.ws + WS_HX2); float* AFF = (float*)(p.ws + WS_AFF);
    for (int row = wg * nwv + wv; row < M; row += nwg * nwv) {
        const int b = row / SEQ; const float* mb = mod + b * 6144;
        const float* g1 = mb + 2048; const float* sh2 = mb + 3072; const float* sc2 = mb + 4096;
        f32x4 mx[4], x1[4]; float ss = 0.f;
#pragma unroll
        for (int j = 0; j < 4; ++j) { mx[j] = ((const f32x4*)(p.out + (size_t)row * D))[lane + 64 * j]; ss += (mx[j][0] * mx[j][0] + mx[j][1] * mx[j][1]) + (mx[j][2] * mx[j][2] + mx[j][3] * mx[j][3]); }
        ss = wave_sum(ss); const float r1 = 1.0f / sqrtf(ss * (1.0f / D) + RMS_EPS);
        float s2 = 0.f;
#pragma unroll
        for (int j = 0; j < 4; ++j) { const int i0 = 4 * lane + 256 * j; const f32x4 xv = *(const f32x4*)(p.x + (size_t)row * D + i0), pg = *(const f32x4*)(p.post_mix_g + i0), gg = *(const f32x4*)(g1 + i0);
#pragma unroll
            for (int q = 0; q < 4; ++q) { x1[j][q] = xv[q] + gg[q] * (mx[j][q] * r1 * pg[q]); s2 += x1[j][q] * x1[j][q]; }
            *(f32x4*)(p.out + (size_t)row * D + i0) = x1[j]; }
        s2 = wave_sum(s2); const float r2 = 1.0f / sqrtf(s2 * (1.0f / D) + RMS_EPS);
        float lg[16];
#pragma unroll
        for (int e = 0; e < 16; ++e) lg[e] = 0.f;
#pragma unroll
        for (int j = 0; j < 4; ++j) { const int i0 = 4 * lane + 256 * j; const f32x4 pg = *(const f32x4*)(p.pre_ffn_g + i0), sc = *(const f32x4*)(sc2 + i0), sh = *(const f32x4*)(sh2 + i0);
            half4 o;
#pragma unroll
            for (int q = 0; q < 4; ++q) { const float hv = x1[j][q] * r2 * pg[q] * (1.0f + sc[q]) + sh[q]; o[q] = (half_t)hv;
                const f32x4* wr = (const f32x4*)(p.w_router + (size_t)(i0 + q) * NE);
#pragma unroll
                for (int e4 = 0; e4 < 4; ++e4) { const f32x4 w = wr[e4]; lg[e4 * 4 + 0] += hv * w[0]; lg[e4 * 4 + 1] += hv * w[1]; lg[e4 * 4 + 2] += hv * w[2]; lg[e4 * 4 + 3] += hv * w[3]; } }
            *(half4*)(HX2 + (size_t)row * D + i0) = o; }
        float mxl = -1e30f;
#pragma unroll
        for (int e = 0; e < 16; ++e) { lg[e] = wave_sum(lg[e]) + p.b_router[e]; mxl = fmaxf(mxl, lg[e]); }
        float den = 0.f;
#pragma unroll
        for (int e = 0; e < 16; ++e) { lg[e] = expf(lg[e] - mxl); den += lg[e]; }
        const float inv = 1.0f / den;
        float mine = 0.f;
#pragma unroll
        for (int e = 0; e < 16; ++e) if (lane == e) mine = lg[e] * inv;
        if (lane < 16) AFF[(size_t)row * NE + lane] = mine;
    }
}
__device__ __forceinline__ int block_sum_i(int v, int* red) {
    __syncthreads();
    const int lane = threadIdx.x & 63, wv = threadIdx.x >> 6, nwv = blockDim.x >> 6;
#pragma unroll
    for (int o = 1; o < 64; o <<= 1) v += __shfl_xor(v, o);
    if (lane == 0) red[wv] = v;
    __syncthreads();
    int s = 0; for (int w = 0; w < nwv; ++w) s += red[w];
    return s;
}
__device__ __forceinline__ int block_exscan_i(int v, int* red) {
    __syncthreads();
    const int lane = threadIdx.x & 63, wv = threadIdx.x >> 6, nwv = blockDim.x >> 6;
    int inc = v;
#pragma unroll
    for (int o = 1; o < 64; o <<= 1) { const int t = __shfl_up(inc, o); if (lane >= o) inc += t; }
    if (lane == 63) red[wv] = inc;
    __syncthreads();
    int base = 0; for (int w = 0; w < nwv; ++w) if (w < wv) base += red[w];
    return base + inc - v;
}
__device__ void ph_topk(const P& p, int wg, int nwg, unsigned* lds) {
    unsigned* vals = lds; int* red = (int*)(lds + SEQ);
    const float* AFF = (const float*)(p.ws + WS_AFF); int* IDX = (int*)(p.ws + WS_IDX); float* GATE = (float*)(p.ws + WS_GATE); int* INV = (int*)(p.ws + WS_INV);
    const int tid = threadIdx.x, nthr = blockDim.x, seg = SEQ / nthr;
    for (int it = wg; it < NB * NE; it += nwg) {
        const int b = it / NE, e = it % NE;
        __syncthreads();
        for (int t = tid; t < SEQ; t += nthr) vals[t] = __float_as_uint(AFF[(size_t)(b * SEQ + t) * NE + e]);
        __syncthreads();
        unsigned T = 0u;
        for (int bit = 30; bit >= 0; --bit) {
            const unsigned cand = T | (1u << bit); int cnt = 0;
            for (int t = tid; t < SEQ; t += nthr) cnt += vals[t] >= cand ? 1 : 0;
            if (block_sum_i(cnt, red) >= CAP) T = cand;
        }
        int cgt = 0, ceq = 0;
        for (int t = tid * seg; t < tid * seg + seg; ++t) { cgt += vals[t] > T ? 1 : 0; ceq += vals[t] == T ? 1 : 0; }
        const int tot_gt = block_sum_i(cgt, red), need = CAP - tot_gt;
        const int tie_base = block_exscan_i(ceq, red);
        int nsel = 0, tr = tie_base;
        for (int t = tid * seg; t < tid * seg + seg; ++t) { if (vals[t] > T) ++nsel; else if (vals[t] == T) { if (tr < need) ++nsel; ++tr; } }
        int slot = block_exscan_i(nsel, red); tr = tie_base;
        for (int t = tid * seg; t < tid * seg + seg; ++t) {
            bool sel = false;
            if (vals[t] > T) sel = true; else if (vals[t] == T) { sel = tr < need; ++tr; }
            if (sel) { IDX[it * CAP + slot] = t; GATE[it * CAP + slot] = __uint_as_float(vals[t]); INV[(size_t)(b * SEQ + t) * NE + e] = slot; ++slot; }
            else INV[(size_t)(b * SEQ + t) * NE + e] = -1;
        }
    }
}
__device__ void ph_combine(const P& p, int wg, int nwg) {
    const int lane = threadIdx.x & 63, wv = threadIdx.x >> 6, nwv = blockDim.x >> 6;
    const float* mod = (const float*)(p.ws + WS_MOD); const int* INV = (const int*)(p.ws + WS_INV); const half_t* Y = (const half_t*)(p.ws + WS_Y);
    for (int row = wg * nwv + wv; row < M; row += nwg * nwv) {
        const int b = row / SEQ; const float* g2 = mod + b * 6144 + 5120;
        f32x4 acc[4];
#pragma unroll
        for (int j = 0; j < 4; ++j) acc[j] = (f32x4){0.f, 0.f, 0.f, 0.f};
        for (int e = 0; e < NE; ++e) { const int slot = INV[(size_t)row * NE + e];
            if (slot >= 0) { const half_t* yr = Y + ((size_t)(b * NE + e) * CAP + slot) * D;
#pragma unroll
                for (int j = 0; j < 4; ++j) { const half4 v = *(const half4*)(yr + 4 * lane + 256 * j); acc[j][0] += (float)v[0]; acc[j][1] += (float)v[1]; acc[j][2] += (float)v[2]; acc[j][3] += (float)v[3]; } } }
        float ss = 0.f;
#pragma unroll
        for (int j = 0; j < 4; ++j) ss += (acc[j][0] * acc[j][0] + acc[j][1] * acc[j][1]) + (acc[j][2] * acc[j][2] + acc[j][3] * acc[j][3]);
        ss = wave_sum(ss); const float r = 1.0f / sqrtf(ss * (1.0f / D) + RMS_EPS);
#pragma unroll
        for (int j = 0; j < 4; ++j) { const int i0 = 4 * lane + 256 * j; const f32x4 x1 = *(const f32x4*)(p.out + (size_t)row * D + i0), pg = *(const f32x4*)(p.post_ffn_g + i0), gg = *(const f32x4*)(g2 + i0);
            f32x4 o;
#pragma unroll
            for (int q = 0; q < 4; ++q) o[q] = x1[q] + gg[q] * (acc[j][q] * r * pg[q]);
            *(f32x4*)(p.out + (size_t)row * D + i0) = o; }
    }
}
extern __shared__ __attribute__((aligned(16))) unsigned char dyn_smem[];
__global__ __launch_bounds__(256) void k_mod_partial(P p) { ph_mod_partial(p, blockIdx.x, gridDim.x); }
__global__ __launch_bounds__(256) void k_mod_reduce(P p) { ph_mod_reduce(p, blockIdx.x, gridDim.x); }
__global__ __launch_bounds__(256) void k_rope(P p) { ph_rope(p, blockIdx.x, gridDim.x); }
__global__ __launch_bounds__(256) void k_prep(P p) { ph_prep_weights(p, blockIdx.x, gridDim.x, (float*)dyn_smem); }
__global__ __launch_bounds__(256) void k_hx(P p) { ph_hx(p, blockIdx.x, gridDim.x); }
__global__ __launch_bounds__(256) void k_r1(P p) { ph_r1(p, blockIdx.x, gridDim.x, (float*)dyn_smem); }
__global__ __launch_bounds__(256) void k_scan(P p) { ph_scan(p, blockIdx.x, gridDim.x); }
__global__ __launch_bounds__(256) void k_r3(P p) { ph_r3(p, blockIdx.x, gridDim.x, (float*)dyn_smem); }
__global__ __launch_bounds__(256) void k_conv(P p) { ph_conv(p, blockIdx.x, gridDim.x); }
__global__ __launch_bounds__(256) void k_postmix(P p) { ph_postmix(p, blockIdx.x, gridDim.x); }
__global__ __launch_bounds__(256) void k_topk(P p) { ph_topk(p, blockIdx.x, gridDim.x, (unsigned*)dyn_smem); }
__global__ __launch_bounds__(256) void k_combine(P p) { ph_combine(p, blockIdx.x, gridDim.x); }

extern "C" void kernel_launch(void* const* d_in, const int* in_sizes, int n_in, void* d_out, int out_size, void* d_ws, size_t ws_size, hipStream_t stream) {
    static int init = 0;
    constexpr int LDS_R1 = (2 * 128 * 128 + 256) * 4, LDS_R3 = (128 * 132 + 128 * 68 + 64 * 132 + 128 + 512) * 4, LDS_PREP = 4 * 64 * 33 * 4, LDS_TOPK = SEQ * 4 + 64, LDS_GEMM = 2 * 128 * 32 * 2;
    if (!init) {
        if (n_in != 21 || ws_size < WS_END || out_size != M * D) { fprintf(stderr, "kernel_launch: unexpected shapes n_in %d ws %zu out %d\n", n_in, ws_size, out_size); init = -1; return; }
        hipFuncSetAttribute((const void*)k_r1, hipFuncAttributeMaxDynamicSharedMemorySize, LDS_R1);
        hipFuncSetAttribute((const void*)k_r3, hipFuncAttributeMaxDynamicSharedMemorySize, LDS_R3);
        init = 1;
    }
    if (init < 0) return;
    P p{};
    const float** f = (const float**)&p;
    for (int i = 0; i < 21; ++i) f[i] = (const float*)d_in[i];
    p.out = (float*)d_out; p.ws = (unsigned char*)d_ws;
    hipLaunchKernelGGL(k_mod_partial, dim3(384), dim3(256), 0, stream, p);
    hipLaunchKernelGGL(k_mod_reduce, dim3(72), dim3(256), 0, stream, p);
    hipLaunchKernelGGL(k_rope, dim3(2112), dim3(256), 0, stream, p);
    hipLaunchKernelGGL(k_prep, dim3(2048), dim3(256), LDS_PREP, stream, p);
    hipLaunchKernelGGL(k_hx, dim3(2112), dim3(256), 0, stream, p);
    hipLaunchKernelGGL(k_gemm128<GemmIn>, dim3(132 * 28), dim3(256), LDS_GEMM, stream, GemmIn(), p);
    hipLaunchKernelGGL(k_r1, dim3(8 * NCHK), dim3(256), LDS_R1, stream, p);
    hipLaunchKernelGGL(k_scan, dim3(1024), dim3(256), 0, stream, p);
    hipLaunchKernelGGL(k_r3, dim3(512), dim3(256), LDS_R3, stream, p);
    hipLaunchKernelGGL(k_conv, dim3(4096), dim3(256), 0, stream, p);
    hipLaunchKernelGGL(k_gemm128<GemmOut>, dim3(128 * 8), dim3(256), LDS_GEMM, stream, GemmOut(), p);
    hipLaunchKernelGGL(k_postmix, dim3(2048), dim3(256), 0, stream, p);
    hipLaunchKernelGGL(k_topk, dim3(32), dim3(256), LDS_TOPK, stream, p);
    hipLaunchKernelGGL(k_gemm128<GemmGU>, dim3(32 * 256), dim3(256), LDS_GEMM, stream, GemmGU(), p);
    hipLaunchKernelGGL(k_gemm128<GemmDown>, dim3(32 * 64), dim3(256), LDS_GEMM, stream, GemmDown(), p);
    hipLaunchKernelGGL(k_combine, dim3(2048), dim3(256), 0, stream, p);
}
```

```cpp
#include <hip/hip_runtime.h>
#include <cstdint>
#include <cstdio>

typedef _Float16 half_t;
typedef _Float16 half8 __attribute__((ext_vector_type(8)));
typedef _Float16 half4 __attribute__((ext_vector_type(4)));
typedef float f32x4 __attribute__((ext_vector_type(4)));

constexpr int D = 1024, NB = 2, SEQ = 8192, M = NB * SEQ, CTXL = 256, MC = NB * CTXL, MR = M + MC;
constexpr int CW = 512, NH = 4, HD = 128, RW = 512, INC = 3584;
constexpr int NCHK = 66;
constexpr int NE = 16, CAP = 1024, DE = 2048;
constexpr float RMS_EPS = 1e-6f, GN_EPS = 1e-6f;

constexpr size_t MiB = 1u << 20;
constexpr size_t WS_CTL = 0;
constexpr size_t WS_MODP = 1 * MiB;
constexpr size_t WS_MOD = 3 * MiB;
constexpr size_t WS_ROPE = 4 * MiB;
constexpr size_t WS_ROPE_SIN = WS_ROPE + 2560 * 1024;
constexpr size_t WS_AFF = 9 * MiB;
constexpr size_t WS_IDX = 10 * MiB;
constexpr size_t WS_GATE = WS_IDX + 256 * 1024;
constexpr size_t WS_INV = 11 * MiB;
constexpr size_t WS_WIN = 12 * MiB;
constexpr size_t WS_WOUT = 19 * MiB;
constexpr size_t WS_WGU = 21 * MiB;
constexpr size_t WS_WD = 149 * MiB;
constexpr size_t WS_A = 213 * MiB;
constexpr size_t WS_HX = WS_A, WS_MIXA = WS_A + 33 * MiB, WS_HX2 = WS_A, WS_Y = WS_A;
constexpr size_t WS_B = 279 * MiB;
constexpr size_t WS_XB = WS_B, WS_XC = WS_B + 16 * MiB, WS_XX = WS_B + 32 * MiB, WS_G = WS_B + 48 * MiB;
constexpr size_t WS_Q = WS_B + 64 * MiB, WS_K = WS_Q + 17 * MiB, WS_V = WS_K + 17 * MiB;
constexpr size_t WS_US = WS_V + 17 * MiB;
constexpr size_t WS_H = WS_B;
constexpr size_t WS_END = WS_US + 66 * MiB;
static_assert(WS_H + 128 * MiB <= WS_END, "H overlay");

struct P {
    const float *x, *c, *ctx, *c_ctx, *w_ada, *b_ada, *pre_mix_g, *post_mix_g, *pre_ffn_g, *post_ffn_g, *w_in, *conv_w, *conv_b, *decay, *ret_norm_g, *w_out,
        *w_router, *b_router, *w_gate, *w_up, *w_down;
    float* out; unsigned char* ws;
};

__device__ __forceinline__ float wave_sum(float v) {
#pragma unroll
    for (int o = 1; o < 64; o <<= 1) v += __shfl_xor(v, o);
    return v;
}
__device__ __forceinline__ float silu_f(float v) { return v / (1.0f + expf(-v)); }
__device__ __forceinline__ float log_sigmoid_f(float v) { return v >= 0.f ? -log1pf(expf(-v)) : v - log1pf(expf(v)); }

__host__ __device__ __forceinline__ int in_col_src(int R) {
    if (R < 1536 || R >= 2560) return R;
    const int base = R & ~127, w = R & 127, span = w >> 6, blk = (w & 63) >> 4, i = w & 15;
    return base + span * 32 + (blk >> 1) * 16 + i + (blk & 1) * 64;
}
constexpr int GU_G = 32;

__device__ void ph_mod_partial(const P& p, int wg, int nwg) {
    const int sub = threadIdx.x >> 8, nsub = blockDim.x >> 8, t = threadIdx.x & 255;
    float* part = (float*)(p.ws + WS_MODP);
    for (int it = wg * nsub + sub; it < 24 * 16; it += nwg * nsub) {
        const int cb = it % 24, ks = it / 24, col = cb * 256 + t;
        float a0 = 0.f, a1 = 0.f, a2 = 0.f;
        for (int k = ks * 64; k < ks * 64 + 64; ++k) {
            const float w = p.w_ada[(size_t)k * 6144 + col];
            a0 += silu_f(p.c[k]) * w; a1 += silu_f(p.c[1024 + k]) * w; a2 += silu_f(p.c_ctx[k]) * w;
        }
        part[(ks * 3 + 0) * 6144 + col] = a0; part[(ks * 3 + 1) * 6144 + col] = a1; part[(ks * 3 + 2) * 6144 + col] = a2;
    }
}
__device__ void ph_mod_reduce(const P& p, int wg, int nwg) {
    const float* part = (const float*)(p.ws + WS_MODP); float* mod = (float*)(p.ws + WS_MOD);
    for (int i = wg * blockDim.x + threadIdx.x; i < 3 * 6144; i += nwg * blockDim.x) {
        const int col = i % 6144; float s = p.b_ada[col];
        for (int ks = 0; ks < 16; ++ks) s += part[ks * 3 * 6144 + i];
        mod[i] = s;
    }
}
__device__ void ph_rope(const P& p, int wg, int nwg) {
    float* ct = (float*)(p.ws + WS_ROPE); float* st = (float*)(p.ws + WS_ROPE_SIN);
    for (int i = wg * blockDim.x + threadIdx.x; i < 8448 * 64; i += nwg * blockDim.x) {
        const int pos = i >> 6, j = i & 63;
        const float inv = 1.0f / powf(10000.0f, (float)j / 64.0f);
        const float ang = (float)pos * inv;
        const double a = (double)ang; const double kk = rint(a * 0.15915494309189535); const double r = a - kk * 6.283185307179586476925;
        ct[i] = (float)cos(r); st[i] = (float)sin(r);
    }
}
template <class Map>
__device__ __forceinline__ void transpose_item(const float* W, int K, int N, half_t* WT, float* scr, int item, int lane, Map srcmap) {
    const int nblk = N / 32, kb = item / nblk, nb = item % nblk, k0 = 64 * kb, n0 = 32 * nb;
    const int scol = srcmap(n0 + (lane & 31));
#pragma unroll 8
    for (int i = 0; i < 32; ++i) { const int kk = 2 * i + (lane >> 5); scr[kk * 33 + (lane & 31)] = W[(size_t)(k0 + kk) * N + scol]; }
    __builtin_amdgcn_s_waitcnt(0xc07f); asm volatile("" ::: "memory");
    const int c = lane & 7;
#pragma unroll
    for (int j = 0; j < 4; ++j) { const int n = (lane >> 3) + 8 * j; const float* s = scr + (8 * c) * 33 + n;
        half8 o;
#pragma unroll
        for (int q = 0; q < 8; ++q) o[q] = (half_t)s[q * 33];
        *(half8*)(WT + (size_t)(n0 + n) * K + k0 + 8 * c) = o; }
    __builtin_amdgcn_s_waitcnt(0xc07f); asm volatile("" ::: "memory");
}
struct MapId { __device__ int operator()(int R) const { return R; } };
struct MapIn { __device__ int operator()(int R) const { return in_col_src(R); } };
__device__ void ph_prep_weights(const P& p, int wg, int nwg, float* lds_f) {
    const int lane = threadIdx.x & 63, wv = threadIdx.x >> 6, nwv = blockDim.x >> 6;
    float* scr = lds_f + wv * (64 * 33);
    half_t* Win = (half_t*)(p.ws + WS_WIN); half_t* Wout = (half_t*)(p.ws + WS_WOUT); half_t* Wgu = (half_t*)(p.ws + WS_WGU); half_t* Wd = (half_t*)(p.ws + WS_WD);
    constexpr int I_IN = (D / 64) * (INC / 32), I_OUT = (D / 64) * (D / 32), I_G = (D / 64) * (DE / 32), I_D = (DE / 64) * (D / 32);
    constexpr int NIT = I_IN + I_OUT + NE * (2 * I_G + I_D);
    for (int it = wg * nwv + wv; it < NIT; it += nwg * nwv) {
        int r = it;
        if (r < I_IN) { transpose_item(p.w_in, D, INC, Win, scr, r, lane, MapIn()); continue; } r -= I_IN;
        if (r < I_OUT) { transpose_item(p.w_out, D, D, Wout, scr, r, lane, MapId()); continue; } r -= I_OUT;
        const int e = r / (2 * I_G + I_D); r -= e * (2 * I_G + I_D);
        if (r < 2 * I_G) {
            const int which = r / I_G, item = r % I_G;
            const float* W = (which ? p.w_up : p.w_gate) + (size_t)e * D * DE;
            const int nblk = DE / 32, kb = item / nblk, nb = item % nblk, k0 = 64 * kb, n0 = 32 * nb;
            half_t* WT = Wgu + (size_t)e * 4096 * D;
#pragma unroll 8
            for (int i = 0; i < 32; ++i) { const int kk = 2 * i + (lane >> 5); scr[kk * 33 + (lane & 31)] = W[(size_t)(k0 + kk) * DE + n0 + (lane & 31)]; }
            __builtin_amdgcn_s_waitcnt(0xc07f); asm volatile("" ::: "memory");
            const int c = lane & 7;
#pragma unroll
            for (int j = 0; j < 4; ++j) { const int n = (lane >> 3) + 8 * j; const float* s = scr + (8 * c) * 33 + n;
                half8 o;
#pragma unroll
                for (int q = 0; q < 8; ++q) o[q] = (half_t)s[q * 33];
                *(half8*)(WT + (size_t)(nb * 64 + which * 32 + n) * D + k0 + 8 * c) = o; }
            __builtin_amdgcn_s_waitcnt(0xc07f); asm volatile("" ::: "memory");
            continue;
        }
        r -= 2 * I_G;
        transpose_item(p.w_down + (size_t)e * DE * D, DE, D, Wd + (size_t)e * D * DE, scr, r, lane, MapId());
    }
}
__device__ void ph_hx(const P& p, int wg, int nwg) {
    const int lane = threadIdx.x & 63, wv = threadIdx.x >> 6, nwv = blockDim.x >> 6;
    const float* mod = (const float*)(p.ws + WS_MOD); half_t* HX = (half_t*)(p.ws + WS_HX);
    for (int row = wg * nwv + wv; row < MR; row += nwg * nwv) {
        const float* src; int mr;
        if (row < M) { src = p.x + (size_t)row * D; mr = row / SEQ; } else { src = p.ctx + (size_t)(row - M) * D; mr = 2; }
        const float* sh = mod + mr * 6144; const float* sc = sh + 1024;
        f32x4 v[4]; float ss = 0.f;
#pragma unroll
        for (int j = 0; j < 4; ++j) { v[j] = ((const f32x4*)src)[lane + 64 * j]; ss += (v[j][0] * v[j][0] + v[j][1] * v[j][1]) + (v[j][2] * v[j][2] + v[j][3] * v[j][3]); }
        ss = wave_sum(ss); const float rstd = 1.0f / sqrtf(ss * (1.0f / D) + RMS_EPS);
#pragma unroll
        for (int j = 0; j < 4; ++j) { const int i0 = 4 * lane + 256 * j;
            const f32x4 g = *(const f32x4*)(p.pre_mix_g + i0), s = *(const f32x4*)(sc + i0), h = *(const f32x4*)(sh + i0);
            half4 o;
#pragma unroll
            for (int q = 0; q < 4; ++q) o[q] = (half_t)(v[j][q] * rstd * g[q] * (1.0f + s[q]) + h[q]);
            *(half4*)(HX + (size_t)row * D + i0) = o; }
    }
}
struct TileInfo { const half_t* Bt; int K; int g, tm, tn; };
template <class G>
__device__ void ph_gemm128(const P& p, G g, int ntiles, int wg, int nwg, unsigned char* lds) {
    const int hw = threadIdx.x >> 8, tid = threadIdx.x & 255, wid = tid >> 6, lane = tid & 63, wr = wid >> 1, wc = wid & 1, fr = lane & 15, fq = lane >> 4;
    half_t* SA = (half_t*)(lds + hw * 16384); half_t* SB = SA + 128 * 32;
    for (int t0 = wg * 2; t0 < ntiles; t0 += nwg * 2) {
        const TileInfo T = g.tile(p, t0 + hw);
        const half_t* arow[2]; const half_t* brow[2];
#pragma unroll
        for (int i = 0; i < 2; ++i) { const int b = tid * 16 + i * 4096, r = b / 64, c = (b % 64) / 2; arow[i] = g.a_row(p, T, r) + c; brow[i] = T.Bt + (size_t)(T.tn * 128 + r) * T.K + c; }
        f32x4 acc[4][4];
#pragma unroll
        for (int m = 0; m < 4; ++m)
#pragma unroll
            for (int n = 0; n < 4; ++n) acc[m][n] = (f32x4){0.f, 0.f, 0.f, 0.f};
        for (int t = 0; t < T.K / 32; ++t) {
#pragma unroll
            for (int i = 0; i < 2; ++i) { const int b = tid * 16 + i * 4096;
                __builtin_amdgcn_global_load_lds((const unsigned*)(arow[i] + t * 32), (unsigned*)((char*)SA + b), 16, 0, 0);
                __builtin_amdgcn_global_load_lds((const unsigned*)(brow[i] + t * 32), (unsigned*)((char*)SB + b), 16, 0, 0); }
            asm volatile("s_waitcnt vmcnt(0)" ::: "memory"); __syncthreads();
            half8 At[4], Bl[4];
#pragma unroll
            for (int m = 0; m < 4; ++m) { At[m] = *(const half8*)((const char*)SA + (wr * 64 + m * 16 + fr) * 64 + fq * 16); Bl[m] = *(const half8*)((const char*)SB + (wc * 64 + m * 16 + fr) * 64 + fq * 16); }
#pragma unroll
            for (int m = 0; m < 4; ++m)
#pragma unroll
                for (int n = 0; n < 4; ++n) acc[m][n] = __builtin_amdgcn_mfma_f32_16x16x32_f16(At[m], Bl[n], acc[m][n], 0, 0, 0);
            __syncthreads();
        }
        g.epi(p, T, acc, wr, wc, fr, fq);
    }
}
struct GemmIn {
    __device__ TileInfo tile(const P& p, int t) const { TileInfo T; T.Bt = (const half_t*)(p.ws + WS_WIN); T.K = D; T.g = 0; T.tm = t / 28; T.tn = t % 28; return T; }
    __device__ const half_t* a_row(const P& p, const TileInfo& T, int r) const { return (const half_t*)(p.ws + WS_HX) + (size_t)(T.tm * 128 + r) * D; }
    __device__ void epi(const P& p, const TileInfo& T, f32x4 (&acc)[4][4], int wr, int wc, int fr, int fq) const {
        const int col0 = T.tn * 128 + wc * 64, sec = col0 / 512, within = col0 % 512;
        const float* ct = (const float*)(p.ws + WS_ROPE); const float* st = (const float*)(p.ws + WS_ROPE_SIN);
#pragma unroll
        for (int m = 0; m < 4; ++m)
#pragma unroll
            for (int j = 0; j < 4; ++j) {
                const int row = T.tm * 128 + wr * 64 + m * 16 + fq * 4 + j;
                if (sec == 3 || sec == 4) {
                    const int hh = within / 128, span = (within % 128) / 64;
                    const int pos = row < M ? CTXL + (row % SEQ) : (row - M) % CTXL;
                    half_t* dst = (half_t*)(p.ws + (sec == 3 ? WS_Q : WS_K)) + (size_t)row * RW + hh * 128;
                    const float scl = sec == 4 ? 0.08838834764831845f : 1.0f;
#pragma unroll
                    for (int n = 0; n < 4; n += 2) {
                        const int d1 = span * 32 + (n >> 1) * 16 + fr;
                        const float cs = ct[pos * 64 + d1], sn = st[pos * 64 + d1];
                        const float t1 = acc[m][n][j], t2 = acc[m][n + 1][j];
                        dst[d1] = (half_t)((t1 * cs - t2 * sn) * scl); dst[d1 + 64] = (half_t)((t1 * sn + t2 * cs) * scl);
                    }
                } else if (sec == 5) {
                    half_t* dst = (half_t*)(p.ws + WS_V) + (size_t)row * RW + within;
#pragma unroll
                    for (int n = 0; n < 4; ++n) dst[n * 16 + fr] = (half_t)acc[m][n][j];
                } else if (row < M) {
                    const size_t off = sec == 0 ? WS_XB : sec == 1 ? WS_XC : sec == 2 ? WS_XX : WS_G;
                    half_t* dst = (half_t*)(p.ws + off) + (size_t)row * CW + within;
#pragma unroll
                    for (int n = 0; n < 4; ++n) dst[n * 16 + fr] = (half_t)acc[m][n][j];
                }
            }
    }
};
struct GemmOut {
    __device__ TileInfo tile(const P& p, int t) const { TileInfo T; T.Bt = (const half_t*)(p.ws + WS_WOUT); T.K = D; T.g = 0; T.tm = t / 8; T.tn = t % 8; return T; }
    __device__ const half_t* a_row(const P& p, const TileInfo& T, int r) const { return (const half_t*)(p.ws + WS_MIXA) + (size_t)(T.tm * 128 + r) * D; }
    __device__ void epi(const P& p, const TileInfo& T, f32x4 (&acc)[4][4], int wr, int wc, int fr, int fq) const {
#pragma unroll
        for (int m = 0; m < 4; ++m)
#pragma unroll
            for (int j = 0; j < 4; ++j) { float* dst = p.out + (size_t)(T.tm * 128 + wr * 64 + m * 16 + fq * 4 + j) * D + T.tn * 128 + wc * 64;
#pragma unroll
                for (int n = 0; n < 4; ++n) dst[n * 16 + fr] = acc[m][n][j]; }
    }
};
struct GemmGU {
    __device__ TileInfo tile(const P& p, int t) const { TileInfo T; T.g = t / 256; const int r = t % 256; T.tm = r / 32; T.tn = r % 32; T.K = D;
        T.Bt = (const half_t*)(p.ws + WS_WGU) + (size_t)(T.g % NE) * 4096 * D; return T; }
    __device__ const half_t* a_row(const P& p, const TileInfo& T, int r) const {
        const int tok = ((const int*)(p.ws + WS_IDX))[T.g * CAP + T.tm * 128 + r]; return (const half_t*)(p.ws + WS_HX2) + (size_t)((T.g / NE) * SEQ + tok) * D; }
    __device__ void epi(const P& p, const TileInfo& T, f32x4 (&acc)[4][4], int wr, int wc, int fr, int fq) const {
        const int chunk = T.tn * 2 + wc;
        half_t* Hb = (half_t*)(p.ws + WS_H) + (size_t)T.g * CAP * DE;
#pragma unroll
        for (int m = 0; m < 4; ++m)
#pragma unroll
            for (int j = 0; j < 4; ++j) { half_t* dst = Hb + (size_t)(T.tm * 128 + wr * 64 + m * 16 + fq * 4 + j) * DE + chunk * 32;
#pragma unroll
                for (int n = 0; n < 2; ++n) { const float a = acc[m][n][j], u = acc[m][n + 2][j]; dst[n * 16 + fr] = (half_t)(silu_f(a) * u); } }
    }
};
struct GemmDown {
    __device__ TileInfo tile(const P& p, int t) const { TileInfo T; T.g = t / 64; const int r = t % 64; T.tm = r / 8; T.tn = r % 8; T.K = DE;
        T.Bt = (const half_t*)(p.ws + WS_WD) + (size_t)(T.g % NE) * D * DE; return T; }
    __device__ const half_t* a_row(const P& p, const TileInfo& T, int r) const { return (const half_t*)(p.ws + WS_H) + (size_t)(T.g * CAP + T.tm * 128 + r) * DE; }
    __device__ void epi(const P& p, const TileInfo& T, f32x4 (&acc)[4][4], int wr, int wc, int fr, int fq) const {
        const float* gate = (const float*)(p.ws + WS_GATE) + T.g * CAP;
        half_t* Yb = (half_t*)(p.ws + WS_Y) + (size_t)T.g * CAP * D;
#pragma unroll
        for (int m = 0; m < 4; ++m)
#pragma unroll
            for (int j = 0; j < 4; ++j) { const int slot = T.tm * 128 + wr * 64 + m * 16 + fq * 4 + j; const float gt = gate[slot];
                half_t* dst = Yb + (size_t)slot * D + T.tn * 128 + wc * 64;
#pragma unroll
                for (int n = 0; n < 4; ++n) dst[n * 16 + fr] = (half_t)(acc[m][n][j] * gt); }
    }
};
__device__ __forceinline__ int chunk_row0(int b, int ch) { return ch < 2 ? M + b * CTXL + ch * 128 : b * SEQ + (ch - 2) * 128; }
__device__ void ph_r1(const P& p, int wg, int nwg, float* lds) {
    float* ks = lds; float* vs = lds + 128 * 128; float* wts = lds + 2 * 128 * 128;
    const half_t* Kb = (const half_t*)(p.ws + WS_K); const half_t* Vb = (const half_t*)(p.ws + WS_V); float* US = (float*)(p.ws + WS_US);
    const int tid = threadIdx.x, nthr = blockDim.x;
    for (int it = wg; it < 8 * NCHK; it += nwg) {
        const int bh = it / NCHK, ch = it % NCHK, b = bh >> 2, h = bh & 3, row0 = chunk_row0(b, ch);
        __syncthreads();
        for (int i = tid; i < 128 * 16; i += nthr) { const int j = i >> 4, c8 = (i & 15) * 8;
            const half8 kv = *(const half8*)(Kb + (size_t)(row0 + j) * RW + h * 128 + c8), vv = *(const half8*)(Vb + (size_t)(row0 + j) * RW + h * 128 + c8);
#pragma unroll
            for (int q = 0; q < 8; ++q) { ks[j * 128 + c8 + q] = (float)kv[q]; vs[j * 128 + c8 + q] = (float)vv[q]; } }
        if (tid < 256) { const int dir = tid >> 7, j = tid & 127; const float lg = log_sigmoid_f(p.decay[dir * 4 + h]); wts[tid] = expf(lg * (dir == 0 ? (float)(127 - j) : (float)j)); }
        __syncthreads();
        for (int mt = tid; mt < 512; mt += nthr) {
            const int dir = mt >> 8, d0 = ((mt & 255) >> 4) * 8, e0 = (mt & 15) * 8;
            float acc[8][8];
#pragma unroll
            for (int x = 0; x < 8; ++x)
#pragma unroll
                for (int y = 0; y < 8; ++y) acc[x][y] = 0.f;
            for (int j = 0; j < 128; ++j) {
                const float w = wts[dir * 128 + j];
                const f32x4 a0 = *(const f32x4*)(ks + j * 128 + d0), a1 = *(const f32x4*)(ks + j * 128 + d0 + 4), b0 = *(const f32x4*)(vs + j * 128 + e0), b1 = *(const f32x4*)(vs + j * 128 + e0 + 4);
                float a[8] = {a0[0] * w, a0[1] * w, a0[2] * w, a0[3] * w, a1[0] * w, a1[1] * w, a1[2] * w, a1[3] * w};
                float bb[8] = {b0[0], b0[1], b0[2], b0[3], b1[0], b1[1], b1[2], b1[3]};
#pragma unroll
                for (int x = 0; x < 8; ++x)
#pragma unroll
                    for (int y = 0; y < 8; ++y) acc[x][y] += a[x] * bb[y];
            }
            float* dst = US + ((size_t)(bh * NCHK + ch) * 2 + dir) * 16384;
#pragma unroll
            for (int x = 0; x < 8; ++x) { *(f32x4*)(dst + (d0 + x) * 128 + e0) = (f32x4){acc[x][0], acc[x][1], acc[x][2], acc[x][3]}; *(f32x4*)(dst + (d0 + x) * 128 + e0 + 4) = (f32x4){acc[x][4], acc[x][5], acc[x][6], acc[x][7]}; }
        }
    }
}
__device__ void ph_scan(const P& p, int wg, int nwg) {
    float* US = (float*)(p.ws + WS_US);
    for (int i = wg * blockDim.x + threadIdx.x; i < 8 * 2 * 16384; i += nwg * blockDim.x) {
        const int el = i & 16383, dir = (i >> 14) & 1, bh = i >> 15, h = bh & 3;
        const float g128 = expf(log_sigmoid_f(p.decay[dir * 4 + h]) * 128.0f);
        float S = 0.f;
        for (int s = 0; s < NCHK; ++s) {
            const int ch = dir == 0 ? s : (s == 0 ? 1 : (s == 1 ? 0 : 67 - s));
            float* ptr = US + ((size_t)(bh * NCHK + ch) * 2 + dir) * 16384 + el;
            const float u = *ptr; *ptr = S; S = g128 * S + u;
        }
    }
}
__device__ void ph_r3(const P& p, int wg, int nwg, float* lds) {
    float* A = lds; float* qT = A + 128 * 132; float* Pm = qT + 128 * 68; float* stats = Pm + 64 * 132; float* dt = stats + 128;
    const half_t* Qb = (const half_t*)(p.ws + WS_Q); const half_t* Kb = (const half_t*)(p.ws + WS_K); const half_t* Vb = (const half_t*)(p.ws + WS_V); const half_t* Gb = (const half_t*)(p.ws + WS_G);
    const float* US = (const float*)(p.ws + WS_US); half_t* MIXA = (half_t*)(p.ws + WS_MIXA);
    const int tid = threadIdx.x, nthr = blockDim.x;
    for (int it = wg; it < 8 * 64; it += nwg) {
        const int bh = it / 64, c = it % 64, b = bh >> 2, h = bh & 3, row0 = b * SEQ + c * 128, ch = c + 2;
        const float lgf = log_sigmoid_f(p.decay[h]), lgb = log_sigmoid_f(p.decay[4 + h]);
        const float* Sf = US + ((size_t)(bh * NCHK + ch) * 2 + 0) * 16384; const float* Sb = Sf + 16384;
        __syncthreads();
        if (tid < 128) { dt[tid] = expf(lgf * (float)tid); dt[128 + tid] = expf(lgb * (float)tid); dt[256 + tid] = expf(lgf * (float)(tid + 1)); dt[384 + tid] = expf(lgb * (float)(128 - tid)); }
        for (int half = 0; half < 2; ++half) {
            __syncthreads();
            for (int i = tid; i < 128 * 16; i += nthr) { const int j = i >> 4, c8 = (i & 15) * 8; const half8 kv = *(const half8*)(Kb + (size_t)(row0 + j) * RW + h * 128 + c8);
#pragma unroll
                for (int q = 0; q < 8; ++q) A[(c8 + q) * 132 + j] = (float)kv[q]; }
            for (int i = tid; i < 64 * 16; i += nthr) { const int j = i >> 4, c8 = (i & 15) * 8; const half8 qv = *(const half8*)(Qb + (size_t)(row0 + half * 64 + j) * RW + h * 128 + c8);
#pragma unroll
                for (int q = 0; q < 8; ++q) qT[(c8 + q) * 68 + j] = (float)qv[q]; }
            __syncthreads();
            for (int mt = tid; mt < 256; mt += nthr) {
                const int i0 = (mt >> 4) * 4, j0 = (mt & 15) * 8;
                float acc[4][8];
#pragma unroll
                for (int x = 0; x < 4; ++x)
#pragma unroll
                    for (int y = 0; y < 8; ++y) acc[x][y] = 0.f;
                for (int d = 0; d < 128; ++d) {
                    const f32x4 a = *(const f32x4*)(qT + d * 68 + i0), b0 = *(const f32x4*)(A + d * 132 + j0), b1 = *(const f32x4*)(A + d * 132 + j0 + 4);
                    const float bb[8] = {b0[0], b0[1], b0[2], b0[3], b1[0], b1[1], b1[2], b1[3]};
#pragma unroll
                    for (int x = 0; x < 4; ++x)
#pragma unroll
                        for (int y = 0; y < 8; ++y) acc[x][y] += a[x] * bb[y];
                }
#pragma unroll
                for (int x = 0; x < 4; ++x)
#pragma unroll
                    for (int y = 0; y < 8; ++y) { const int i = half * 64 + i0 + x, j = j0 + y; const float dd = i >= j ? dt[i - j] : dt[128 + j - i]; Pm[(i0 + x) * 132 + j] = acc[x][y] * dd; }
            }
            __syncthreads();
            for (int i = tid; i < 128 * 16; i += nthr) { const int j = i >> 4, c8 = (i & 15) * 8; const half8 vv = *(const half8*)(Vb + (size_t)(row0 + j) * RW + h * 128 + c8);
#pragma unroll
                for (int q = 0; q < 8; ++q) A[j * 132 + c8 + q] = (float)vv[q]; }
            __syncthreads();
            float yacc[4][8]; int yi0 = 0, ye0 = 0; const bool active = tid < 256;
            if (active) {
                const int mt = tid; yi0 = (mt >> 4) * 4; ye0 = (mt & 15) * 8;
#pragma unroll
                for (int x = 0; x < 4; ++x)
#pragma unroll
                    for (int y = 0; y < 8; ++y) yacc[x][y] = 0.f;
                for (int j = 0; j < 128; ++j) {
                    const f32x4 b0 = *(const f32x4*)(A + j * 132 + ye0), b1 = *(const f32x4*)(A + j * 132 + ye0 + 4);
                    const float bb[8] = {b0[0], b0[1], b0[2], b0[3], b1[0], b1[1], b1[2], b1[3]};
#pragma unroll
                    for (int x = 0; x < 4; ++x) { const float a = Pm[(yi0 + x) * 132 + j];
#pragma unroll
                        for (int y = 0; y < 8; ++y) yacc[x][y] += a * bb[y]; }
                }
                float xf[4], xb[4];
#pragma unroll
                for (int x = 0; x < 4; ++x) { xf[x] = dt[256 + half * 64 + yi0 + x]; xb[x] = dt[384 + half * 64 + yi0 + x]; }
                for (int d = 0; d < 128; ++d) {
                    const f32x4 q4 = *(const f32x4*)(qT + d * 68 + yi0);
                    const f32x4 f0 = *(const f32x4*)(Sf + d * 128 + ye0), f1 = *(const f32x4*)(Sf + d * 128 + ye0 + 4), g0 = *(const f32x4*)(Sb + d * 128 + ye0), g1 = *(const f32x4*)(Sb + d * 128 + ye0 + 4);
                    const float ff[8] = {f0[0], f0[1], f0[2], f0[3], f1[0], f1[1], f1[2], f1[3]}; const float gg[8] = {g0[0], g0[1], g0[2], g0[3], g1[0], g1[1], g1[2], g1[3]};
#pragma unroll
                    for (int x = 0; x < 4; ++x) { const float qf = q4[x] * xf[x], qb = q4[x] * xb[x];
#pragma unroll
                        for (int y = 0; y < 8; ++y) yacc[x][y] += qf * ff[y] + qb * gg[y]; }
                }
            }
            __syncthreads();
            if (active) {
#pragma unroll
                for (int x = 0; x < 4; ++x)
#pragma unroll
                    for (int y = 0; y < 8; ++y) Pm[(yi0 + x) * 132 + ye0 + y] = yacc[x][y];
            }
            __syncthreads();
            if (tid < 64) { float s = 0.f; for (int e = 0; e < 128; ++e) s += Pm[tid * 132 + e]; const float mu = s * (1.0f / 128.0f); float q = 0.f;
                for (int e = 0; e < 128; ++e) { const float dlt = Pm[tid * 132 + e] - mu; q += dlt * dlt; }
                stats[tid * 2] = mu; stats[tid * 2 + 1] = 1.0f / sqrtf(q * (1.0f / 128.0f) + GN_EPS); }
            __syncthreads();
            for (int i = tid; i < 64 * 128; i += nthr) { const int r = i >> 7, e = i & 127, row = row0 + half * 64 + r;
                const float yn = (Pm[r * 132 + e] - stats[r * 2]) * stats[r * 2 + 1] * p.ret_norm_g[h * 128 + e];
                const float gv = (float)Gb[(size_t)row * CW + h * 128 + e];
                MIXA[(size_t)row * D + CW + h * 128 + e] = (half_t)(silu_f(gv) * yn); }
        }
    }
}
__device__ void ph_conv(const P& p, int wg, int nwg) {
    const half_t* XB = (const half_t*)(p.ws + WS_XB); const half_t* XC = (const half_t*)(p.ws + WS_XC); const half_t* XX = (const half_t*)(p.ws + WS_XX); half_t* MIXA = (half_t*)(p.ws + WS_MIXA);
    for (int i = wg * blockDim.x + threadIdx.x; i < M * 64; i += nwg * blockDim.x) {
        const int row = i >> 6, ch0 = (i & 63) * 8, n = row & 63;
        const size_t o = (size_t)row * CW + ch0;
        const half8 c1 = *(const half8*)(XC + o), x1 = *(const half8*)(XX + o), bb = *(const half8*)(XB + o);
        half8 c0 = c1, x0 = x1, c2 = c1, x2 = x1;
        if (n != 0) { c0 = *(const half8*)(XC + o - CW); x0 = *(const half8*)(XX + o - CW); }
        if (n != 63) { c2 = *(const half8*)(XC + o + CW); x2 = *(const half8*)(XX + o + CW); }
        half8 r;
#pragma unroll
        for (int q = 0; q < 8; ++q) {
            const float up = n != 0 ? (float)c0[q] * (float)x0[q] : 0.f, u = (float)c1[q] * (float)x1[q], un = n != 63 ? (float)c2[q] * (float)x2[q] : 0.f;
            const float y = up * p.conv_w[ch0 + q] + u * p.conv_w[CW + ch0 + q] + un * p.conv_w[2 * CW + ch0 + q] + p.conv_b[ch0 + q];
            r[q] = (half_t)((float)bb[q] * y);
        }
        *(half8*)(MIXA + (size_t)row * D + ch0) = r;
    }
}
__device__ void ph_postmix(const P& p, int wg, int nwg) {
    const int lane = threadIdx.x & 63, wv = threadIdx.x >> 6, nwv = blockDim.x >> 6;
    const float* mod = (const float*)(p.ws + WS_MOD); half_t* HX2 = (half_t*)(p.ws + WS_HX2); float* AFF = (float*)(p.ws + WS_AFF);
    for (int row = wg * nwv + wv; row < M; row += nwg * nwv) {
        const int b = row / SEQ; const float* mb = mod + b * 6144;
        const float* g1 = mb + 2048; const float* sh2 = mb + 3072; const float* sc2 = mb + 4096;
        f32x4 mx[4], x1[4]; float ss = 0.f;
#pragma unroll
        for (int j = 0; j < 4; ++j) { mx[j] = ((const f32x4*)(p.out + (size_t)row * D))[lane + 64 * j]; ss += (mx[j][0] * mx[j][0] + mx[j][1] * mx[j][1]) + (mx[j][2] * mx[j][2] + mx[j][3] * mx[j][3]); }
        ss = wave_sum(ss); const float r1 = 1.0f / sqrtf(ss * (1.0f / D) + RMS_EPS);
        float s2 = 0.f;
#pragma unroll
        for (int j = 0; j < 4; ++j) { const int i0 = 4 * lane + 256 * j; const f32x4 xv = *(const f32x4*)(p.x + (size_t)row * D + i0), pg = *(const f32x4*)(p.post_mix_g + i0), gg = *(const f32x4*)(g1 + i0);
#pragma unroll
            for (int q = 0; q < 4; ++q) { x1[j][q] = xv[q] + gg[q] * (mx[j][q] * r1 * pg[q]); s2 += x1[j][q] * x1[j][q]; }
            *(f32x4*)(p.out + (size_t)row * D + i0) = x1[j]; }
        s2 = wave_sum(s2); const float r2 = 1.0f / sqrtf(s2 * (1.0f / D) + RMS_EPS);
        float lg[16];
#pragma unroll
        for (int e = 0; e < 16; ++e) lg[e] = 0.f;
#pragma unroll
        for (int j = 0; j < 4; ++j) { const int i0 = 4 * lane + 256 * j; const f32x4 pg = *(const f32x4*)(p.pre_ffn_g + i0), sc = *(const f32x4*)(sc2 + i0), sh = *(const f32x4*)(sh2 + i0);
            half4 o;
#pragma unroll
            for (int q = 0; q < 4; ++q) { const float hv = x1[j][q] * r2 * pg[q] * (1.0f + sc[q]) + sh[q]; o[q] = (half_t)hv;
                const f32x4* wr = (const f32x4*)(p.w_router + (size_t)(i0 + q) * NE);
#pragma unroll
                for (int e4 = 0; e4 < 4; ++e4) { const f32x4 w = wr[e4]; lg[e4 * 4 + 0] += hv * w[0]; lg[e4 * 4 + 1] += hv * w[1]; lg[e4 * 4 + 2] += hv * w[2]; lg[e4 * 4 + 3] += hv * w[3]; } }
            *(half4*)(HX2 + (size_t)row * D + i0) = o; }
        float mxl = -1e30f;
#pragma unroll
        for (int e = 0; e < 16; ++e) { lg[e] = wave_sum(lg[e]) + p.b_router[e]; mxl = fmaxf(mxl, lg[e]); }
        float den = 0.f;
#pragma unroll
        for (int e = 0; e < 16; ++e) { lg[e] = expf(lg[e] - mxl); den += lg[e]; }
        const float inv = 1.0f / den;
        float mine = 0.f;
#pragma unroll
        for (int e = 0; e < 16; ++e) if (lane == e) mine = lg[e] * inv;
        if (lane < 16) AFF[(size_t)row * NE + lane] = mine;
    }
}
__device__ __forceinline__ int block_sum_i(int v, int* red) {
    __syncthreads();
    const int lane = threadIdx.x & 63, wv = threadIdx.x >> 6, nwv = blockDim.x >> 6;
#pragma unroll
    for (int o = 1; o < 64; o <<= 1) v += __shfl_xor(v, o);
    if (lane == 0) red[wv] = v;
    __syncthreads();
    int s = 0; for (int w = 0; w < nwv; ++w) s += red[w];
    return s;
}
__device__ __forceinline__ int block_exscan_i(int v, int* red) {
    __syncthreads();
    const int lane = threadIdx.x & 63, wv = threadIdx.x >> 6, nwv = blockDim.x >> 6;
    int inc = v;
#pragma unroll
    for (int o = 1; o < 64; o <<= 1) { const int t = __shfl_up(inc, o); if (lane >= o) inc += t; }
    if (lane == 63) red[wv] = inc;
    __syncthreads();
    int base = 0; for (int w = 0; w < nwv; ++w) if (w < wv) base += red[w];
    return base + inc - v;
}
__device__ void ph_topk(const P& p, int wg, int nwg, unsigned* lds) {
    unsigned* vals = lds; int* red = (int*)(lds + SEQ);
    const float* AFF = (const float*)(p.ws + WS_AFF); int* IDX = (int*)(p.ws + WS_IDX); float* GATE = (float*)(p.ws + WS_GATE); int* INV = (int*)(p.ws + WS_INV);
    const int tid = threadIdx.x, nthr = blockDim.x, seg = SEQ / nthr;
    for (int it = wg; it < NB * NE; it += nwg) {
        const int b = it / NE, e = it % NE;
        __syncthreads();
        for (int t = tid; t < SEQ; t += nthr) vals[t] = __float_as_uint(AFF[(size_t)(b * SEQ + t) * NE + e]);
        __syncthreads();
        unsigned T = 0u;
        for (int bit = 30; bit >= 0; --bit) {
            const unsigned cand = T | (1u << bit); int cnt = 0;
            for (int t = tid; t < SEQ; t += nthr) cnt += vals[t] >= cand ? 1 : 0;
            if (block_sum_i(cnt, red) >= CAP) T = cand;
        }
        int cgt = 0, ceq = 0;
        for (int t = tid * seg; t < tid * seg + seg; ++t) { cgt += vals[t] > T ? 1 : 0; ceq += vals[t] == T ? 1 : 0; }
        const int tot_gt = block_sum_i(cgt, red), need = CAP - tot_gt;
        const int tie_base = block_exscan_i(ceq, red);
        int nsel = 0, tr = tie_base;
        for (int t = tid * seg; t < tid * seg + seg; ++t) { if (vals[t] > T) ++nsel; else if (vals[t] == T) { if (tr < need) ++nsel; ++tr; } }
        int slot = block_exscan_i(nsel, red); tr = tie_base;
        for (int t = tid * seg; t < tid * seg + seg; ++t) {
            bool sel = false;
            if (vals[t] > T) sel = true; else if (vals[t] == T) { sel = tr < need; ++tr; }
            if (sel) { IDX[it * CAP + slot] = t; GATE[it * CAP + slot] = __uint_as_float(vals[t]); INV[(size_t)(b * SEQ + t) * NE + e] = slot; ++slot; }
            else INV[(size_t)(b * SEQ + t) * NE + e] = -1;
        }
    }
}
__device__ void ph_combine(const P& p, int wg, int nwg) {
    const int lane = threadIdx.x & 63, wv = threadIdx.x >> 6, nwv = blockDim.x >> 6;
    const float* mod = (const float*)(p.ws + WS_MOD); const int* INV = (const int*)(p.ws + WS_INV); const half_t* Y = (const half_t*)(p.ws + WS_Y);
    for (int row = wg * nwv + wv; row < M; row += nwg * nwv) {
        const int b = row / SEQ; const float* g2 = mod + b * 6144 + 5120;
        f32x4 acc[4];
#pragma unroll
        for (int j = 0; j < 4; ++j) acc[j] = (f32x4){0.f, 0.f, 0.f, 0.f};
        for (int e = 0; e < NE; ++e) { const int slot = INV[(size_t)row * NE + e];
            if (slot >= 0) { const half_t* yr = Y + ((size_t)(b * NE + e) * CAP + slot) * D;
#pragma unroll
                for (int j = 0; j < 4; ++j) { const half4 v = *(const half4*)(yr + 4 * lane + 256 * j); acc[j][0] += (float)v[0]; acc[j][1] += (float)v[1]; acc[j][2] += (float)v[2]; acc[j][3] += (float)v[3]; } } }
        float ss = 0.f;
#pragma unroll
        for (int j = 0; j < 4; ++j) ss += (acc[j][0] * acc[j][0] + acc[j][1] * acc[j][1]) + (acc[j][2] * acc[j][2] + acc[j][3] * acc[j][3]);
        ss = wave_sum(ss); const float r = 1.0f / sqrtf(ss * (1.0f / D) + RMS_EPS);
#pragma unroll
        for (int j = 0; j < 4; ++j) { const int i0 = 4 * lane + 256 * j; const f32x4 x1 = *(const f32x4*)(p.out + (size_t)row * D + i0), pg = *(const f32x4*)(p.post_ffn_g + i0), gg = *(const f32x4*)(g2 + i0);
            f32x4 o;
#pragma unroll
            for (int q = 0; q < 4; ++q) o[q] = x1[q] + gg[q] * (acc[j][q] * r * pg[q]);
            *(f32x4*)(p.out + (size_t)row * D + i0) = o; }
    }
}
#define LAS __attribute__((address_space(3)))
#define XB_TMO      128
#define XB_XCNT(j)  (256  + 64 * (j))
#define XB_XSUB(j)  (1280 + 64 * (j))
#define XB_XGEN(j)  (2304 + 64 * (j))
#define XB_TOP      3328
#define XB_TOPGEN   3392
#define XCD_BAR_WORDS 3456
#define XB_SPIN_CAP (1u << 18)
__device__ __forceinline__ unsigned xb_ld(unsigned* p)              { return __hip_atomic_load(p, __ATOMIC_RELAXED, __HIP_MEMORY_SCOPE_AGENT); }
__device__ __forceinline__ unsigned xb_add(unsigned* p, unsigned v) { return __hip_atomic_fetch_add(p, v, __ATOMIC_RELAXED, __HIP_MEMORY_SCOPE_AGENT); }
__device__ __forceinline__ unsigned xb_xcc_id() { return (unsigned)__builtin_amdgcn_s_getreg((3 << 11) | 20) & 0xFu; }
#define XB_SPIN(cond, bar) do { unsigned _sp = 0; while (cond) { __builtin_amdgcn_s_sleep(1); \
    if ((++_sp & 255u) == 0u) { if (xb_ld(&(bar)[XB_TMO])) break; if (_sp > XB_SPIN_CAP) { atomicAdd(&(bar)[XB_TMO], 1u); break; } } } } while (0)
struct XcdBarrier { unsigned* bar; unsigned x; volatile LAS unsigned* st; };
__device__ __forceinline__ XcdBarrier xcd_barrier_post(unsigned* bar, volatile LAS unsigned* st) {
    XcdBarrier b; b.bar = bar; b.x = xb_xcc_id(); b.st = st;
    if (threadIdx.x == 0) (void)xb_add(&bar[XB_XCNT(b.x)], 1u);
    return b;
}
__device__ __forceinline__ void xcd_barrier_complete(unsigned* bar, unsigned x, unsigned& nloc, unsigned& nx) {
    const unsigned G = gridDim.x * gridDim.y * gridDim.z;
    unsigned sum, cnt, mine, sp = 0u;
    for (;;) {
        sum = 0u; cnt = 0u; mine = 0u;
#pragma unroll
        for (unsigned j = 0; j < 16; ++j) { const unsigned c = xb_ld(&bar[XB_XCNT(j)]); sum += c; cnt += (c > 0u) ? 1u : 0u; mine = (j == x) ? c : mine; }
        if (sum == G) break;
        __builtin_amdgcn_s_sleep(1);
        if ((++sp & 255u) == 0u) { if (xb_ld(&bar[XB_TMO])) break; if (sp > XB_SPIN_CAP) { atomicAdd(&bar[XB_TMO], 1u); break; } }
    }
    nloc = mine > 0u ? mine : 1u; nx = cnt > 0u ? cnt : 1u;
}
__device__ __forceinline__ void xcd_barrier(const XcdBarrier& b) {
    asm volatile("s_waitcnt vmcnt(0)" ::: "memory");
    __syncthreads();
    if (threadIdx.x == 0) {
        unsigned* bar = b.bar;
        __builtin_amdgcn_s_waitcnt(0);
        unsigned nloc = b.st[0], nx = b.st[1];
        if (nloc == 0u) { xcd_barrier_complete(bar, b.x, nloc, nx); b.st[0] = nloc; b.st[1] = nx; }
        const unsigned old = xb_add(&bar[XB_XSUB(b.x)], 1u);
        const unsigned gen = old / nloc;
        if (old + 1u == (gen + 1u) * nloc) {
            __builtin_amdgcn_fence(__ATOMIC_RELEASE, "agent");
            asm volatile("s_waitcnt vmcnt(0)" ::: "memory");
            const unsigned og = xb_add(&bar[XB_TOP], 1u);
            const unsigned tg = og / nx;
            if (og + 1u == (tg + 1u) * nx) xb_add(&bar[XB_TOPGEN], 1u);
            else XB_SPIN(xb_ld(&bar[XB_TOPGEN]) == tg, bar);
            __builtin_amdgcn_fence(__ATOMIC_ACQUIRE, "agent");
            xb_add(&bar[XB_XGEN(b.x)], 1u);
            asm volatile("s_waitcnt vmcnt(0)" ::: "memory");
        } else {
            XB_SPIN(xb_ld(&bar[XB_XGEN(b.x)]) == gen, bar);
            __builtin_amdgcn_fence(__ATOMIC_ACQUIRE, "agent");
            asm volatile("s_waitcnt vmcnt(0)" ::: "memory");
        }
    }
    __syncthreads();
}
constexpr int LDS_BYTES = 147456;
constexpr int MISC_OFF = LDS_BYTES - 128;
constexpr size_t CTL_ZERO_BYTES = 65536;
__global__ void __launch_bounds__(512, 2) mega_fwd(P p) {
    extern __shared__ __attribute__((aligned(16))) unsigned char lds[];
    const int wg = blockIdx.x, nwg = gridDim.x;
    volatile LAS unsigned* MISC = (volatile LAS unsigned*)((LAS unsigned char*)lds + MISC_OFF);
    if (threadIdx.x < 32) MISC[threadIdx.x] = 0u;
    __syncthreads();
    const XcdBarrier bar = xcd_barrier_post((unsigned*)(p.ws + WS_CTL) + 4096, MISC + 8);
    ph_mod_partial(p, wg, nwg); ph_rope(p, wg, nwg); ph_prep_weights(p, wg, nwg, (float*)lds);
    xcd_barrier(bar);
    ph_mod_reduce(p, wg, nwg);
    xcd_barrier(bar);
    ph_hx(p, wg, nwg);
    xcd_barrier(bar);
    ph_gemm128(p, GemmIn(), 132 * 28, wg, nwg, lds);
    xcd_barrier(bar);
    ph_r1(p, wg, nwg, (float*)lds); ph_conv(p, wg, nwg);
    xcd_barrier(bar);
    ph_scan(p, wg, nwg);
    xcd_barrier(bar);
    ph_r3(p, wg, nwg, (float*)lds);
    xcd_barrier(bar);
    ph_gemm128(p, GemmOut(), 128 * 8, wg, nwg, lds);
    xcd_barrier(bar);
    ph_postmix(p, wg, nwg);
    xcd_barrier(bar);
    ph_topk(p, wg, nwg, (unsigned*)lds);
    xcd_barrier(bar);
    ph_gemm128(p, GemmGU(), 32 * 256, wg, nwg, lds);
    xcd_barrier(bar);
    ph_gemm128(p, GemmDown(), 32 * 64, wg, nwg, lds);
    xcd_barrier(bar);
    ph_combine(p, wg, nwg);
}

extern "C" void kernel_launch(void* const* d_in, const int* in_sizes, int n_in, void* d_out, int out_size, void* d_ws, size_t ws_size, hipStream_t stream) {
    static int grid = 0;
    if (grid == 0) {
        if (n_in != 21 || ws_size < WS_END || out_size != M * D) { fprintf(stderr, "kernel_launch: unexpected shapes n_in %d ws %zu out %d\n", n_in, ws_size, out_size); grid = -1; return; }
        int dev = 0, cus = 0, per_cu = 0;
        if (hipGetDevice(&dev) != hipSuccess || hipDeviceGetAttribute(&cus, hipDeviceAttributeMultiprocessorCount, dev) != hipSuccess) { grid = -1; return; }
        if (hipFuncSetAttribute((const void*)mega_fwd, hipFuncAttributeMaxDynamicSharedMemorySize, LDS_BYTES) != hipSuccess) { fprintf(stderr, "kernel_launch: hipFuncSetAttribute failed\n"); grid = -1; return; }
        if (hipOccupancyMaxActiveBlocksPerMultiprocessor(&per_cu, (const void*)mega_fwd, 512, LDS_BYTES) != hipSuccess || per_cu < 1) { fprintf(stderr, "kernel_launch: occupancy query says %d\n", per_cu); (void)hipGetLastError(); per_cu = 1; }
        grid = cus;
    }
    if (grid < 0) return;
    if (hipMemsetAsync((char*)d_ws + WS_CTL, 0, CTL_ZERO_BYTES, stream) != hipSuccess) return;
    P p{};
    const float** f = (const float**)&p;
    for (int i = 0; i < 21; ++i) f[i] = (const float*)d_in[i];
    p.out = (float*)d_out; p.ws = (unsigned char*)d_ws;
    hipLaunchKernelGGL(mega_fwd, dim3(grid), dim3(512), LDS_BYTES, stream, p);
}
```

```cpp
#include <hip/hip_runtime.h>
#include <cstdint>
#include <cstdio>

typedef _Float16 half_t;
typedef _Float16 half8 __attribute__((ext_vector_type(8)));
typedef _Float16 half4 __attribute__((ext_vector_type(4)));
typedef float f32x4 __attribute__((ext_vector_type(4)));

constexpr int D = 1024, NB = 2, SEQ = 8192, M = NB * SEQ, CTXL = 256, MC = NB * CTXL, MR = M + MC;
constexpr int CW = 512, NH = 4, HD = 128, RW = 512, INC = 3584;
constexpr int NCHK = 66;
constexpr int NE = 16, CAP = 1024, DE = 2048;
constexpr float RMS_EPS = 1e-6f, GN_EPS = 1e-6f;

constexpr size_t MiB = 1u << 20;
constexpr size_t WS_CTL = 0;
constexpr size_t WS_MODP = 1 * MiB;
constexpr size_t WS_MOD = 3 * MiB;
constexpr size_t WS_ROPE = 4 * MiB;
constexpr size_t WS_ROPE_SIN = WS_ROPE + 2560 * 1024;
constexpr size_t WS_AFF = 9 * MiB;
constexpr size_t WS_IDX = 10 * MiB;
constexpr size_t WS_GATE = WS_IDX + 256 * 1024;
constexpr size_t WS_INV = 11 * MiB;
constexpr size_t WS_WIN = 12 * MiB;
constexpr size_t WS_WOUT = 19 * MiB;
constexpr size_t WS_WGU = 21 * MiB;
constexpr size_t WS_WD = 149 * MiB;
constexpr size_t WS_A = 213 * MiB;
constexpr size_t WS_HX = WS_A, WS_MIXA = WS_A + 33 * MiB, WS_HX2 = WS_A, WS_Y = WS_A;
constexpr size_t WS_SH = WS_A;
constexpr size_t WS_B = 279 * MiB;
constexpr size_t WS_XB = WS_B, WS_XC = WS_B + 16 * MiB, WS_XX = WS_B + 32 * MiB, WS_G = WS_B + 48 * MiB;
constexpr size_t WS_Q = WS_B + 64 * MiB, WS_K = WS_Q + 17 * MiB, WS_V = WS_K + 17 * MiB;
constexpr size_t WS_US = WS_V + 17 * MiB;
constexpr size_t WS_H = WS_B;
constexpr size_t WS_END = WS_US + 66 * MiB;
static_assert(WS_H + 128 * MiB <= WS_END, "H overlay");

struct P {
    const float *x, *c, *ctx, *c_ctx, *w_ada, *b_ada, *pre_mix_g, *post_mix_g, *pre_ffn_g, *post_ffn_g, *w_in, *conv_w, *conv_b, *decay, *ret_norm_g, *w_out,
        *w_router, *b_router, *w_gate, *w_up, *w_down;
    float* out; unsigned char* ws;
};

__device__ __forceinline__ float wave_sum(float v) {
#pragma unroll
    for (int o = 1; o < 64; o <<= 1) v += __shfl_xor(v, o);
    return v;
}
__device__ __forceinline__ float silu_f(float v) { return v / (1.0f + expf(-v)); }
__device__ __forceinline__ float log_sigmoid_f(float v) { return v >= 0.f ? -log1pf(expf(-v)) : v - log1pf(expf(v)); }

__host__ __device__ __forceinline__ int in_col_src(int R) {
    if (R < 1536 || R >= 2560) return R;
    const int sec_base = R < 2048 ? 1536 : 2048, r = R - sec_base, t = r >> 8, c = r & 255, hi = c >> 7, cc = c & 127;
    return sec_base + (2 * t + (cc >> 6)) * 128 + hi * 64 + (cc & 63);
}

__device__ void ph_mod_partial(const P& p, int wg, int nwg) {
    const int sub = threadIdx.x >> 8, nsub = blockDim.x >> 8, t = threadIdx.x & 255;
    float* part = (float*)(p.ws + WS_MODP);
    for (int it = wg * nsub + sub; it < 24 * 16; it += nwg * nsub) {
        const int cb = it % 24, ks = it / 24, col = cb * 256 + t;
        float a0 = 0.f, a1 = 0.f, a2 = 0.f;
        for (int k = ks * 64; k < ks * 64 + 64; ++k) {
            const float w = p.w_ada[(size_t)k * 6144 + col];
            a0 += silu_f(p.c[k]) * w; a1 += silu_f(p.c[1024 + k]) * w; a2 += silu_f(p.c_ctx[k]) * w;
        }
        part[(ks * 3 + 0) * 6144 + col] = a0; part[(ks * 3 + 1) * 6144 + col] = a1; part[(ks * 3 + 2) * 6144 + col] = a2;
    }
}
__device__ void ph_mod_reduce(const P& p, int wg, int nwg) {
    const float* part = (const float*)(p.ws + WS_MODP); float* mod = (float*)(p.ws + WS_MOD);
    for (int i = wg * blockDim.x + threadIdx.x; i < 3 * 6144; i += nwg * blockDim.x) {
        const int col = i % 6144; float s = p.b_ada[col];
        for (int ks = 0; ks < 16; ++ks) s += part[ks * 3 * 6144 + i];
        mod[i] = s;
    }
}
__device__ void ph_rope(const P& p, int wg, int nwg) {
    float* ct = (float*)(p.ws + WS_ROPE); float* st = (float*)(p.ws + WS_ROPE_SIN);
    for (int i = wg * blockDim.x + threadIdx.x; i < 8448 * 64; i += nwg * blockDim.x) {
        const int pos = i >> 6, j = i & 63;
        const float inv = 1.0f / powf(10000.0f, (float)j / 64.0f);
        const float ang = (float)pos * inv;
        const double a = (double)ang; const double kk = rint(a * 0.15915494309189535); const double r = a - kk * 6.283185307179586476925;
        ct[i] = (float)cos(r); st[i] = (float)sin(r);
    }
}
template <class Map>
__device__ __forceinline__ void transpose_item(const float* W, int K, int N, half_t* WT, float* scr, int item, int lane, Map srcmap) {
    const int nblk = N / 32, kb = item / nblk, nb = item % nblk, k0 = 64 * kb, n0 = 32 * nb;
    const int scol = srcmap(n0 + (lane & 31));
#pragma unroll 8
    for (int i = 0; i < 32; ++i) { const int kk = 2 * i + (lane >> 5); scr[kk * 33 + (lane & 31)] = W[(size_t)(k0 + kk) * N + scol]; }
    __builtin_amdgcn_s_waitcnt(0xc07f); asm volatile("" ::: "memory");
    const int c = lane & 7;
#pragma unroll
    for (int j = 0; j < 4; ++j) { const int n = (lane >> 3) + 8 * j; const float* s = scr + (8 * c) * 33 + n;
        half8 o;
#pragma unroll
        for (int q = 0; q < 8; ++q) o[q] = (half_t)s[q * 33];
        *(half8*)(WT + (size_t)(n0 + n) * K + k0 + 8 * c) = o; }
    __builtin_amdgcn_s_waitcnt(0xc07f); asm volatile("" ::: "memory");
}
struct MapId { __device__ int operator()(int R) const { return R; } };
struct MapIn { __device__ int operator()(int R) const { return in_col_src(R); } };
__device__ void ph_prep_weights(const P& p, int wg, int nwg, float* lds_f) {
    const int lane = threadIdx.x & 63, wv = threadIdx.x >> 6, nwv = blockDim.x >> 6;
    float* scr = lds_f + wv * (64 * 33);
    half_t* Win = (half_t*)(p.ws + WS_WIN); half_t* Wout = (half_t*)(p.ws + WS_WOUT); half_t* Wgu = (half_t*)(p.ws + WS_WGU); half_t* Wd = (half_t*)(p.ws + WS_WD);
    constexpr int I_IN = (D / 64) * (INC / 32), I_OUT = (D / 64) * (D / 32), I_G = (D / 64) * (DE / 32), I_D = (DE / 64) * (D / 32);
    constexpr int NIT = I_IN + I_OUT + NE * (2 * I_G + I_D);
    for (int it = wg * nwv + wv; it < NIT; it += nwg * nwv) {
        int r = it;
        if (r < I_IN) { transpose_item(p.w_in, D, INC, Win, scr, r, lane, MapIn()); continue; } r -= I_IN;
        if (r < I_OUT) { transpose_item(p.w_out, D, D, Wout, scr, r, lane, MapId()); continue; } r -= I_OUT;
        const int e = r / (2 * I_G + I_D); r -= e * (2 * I_G + I_D);
        if (r < 2 * I_G) {
            const int which = r / I_G, item = r % I_G;
            const float* W = (which ? p.w_up : p.w_gate) + (size_t)e * D * DE;
            const int nblk = DE / 32, kb = item / nblk, nb = item % nblk, k0 = 64 * kb, n0 = 32 * nb;
            half_t* WT = Wgu + (size_t)e * 4096 * D;
#pragma unroll 8
            for (int i = 0; i < 32; ++i) { const int kk = 2 * i + (lane >> 5); scr[kk * 33 + (lane & 31)] = W[(size_t)(k0 + kk) * DE + n0 + (lane & 31)]; }
            __builtin_amdgcn_s_waitcnt(0xc07f); asm volatile("" ::: "memory");
            const int c = lane & 7;
#pragma unroll
            for (int j = 0; j < 4; ++j) { const int n = (lane >> 3) + 8 * j; const float* s = scr + (8 * c) * 33 + n;
                half8 o;
#pragma unroll
                for (int q = 0; q < 8; ++q) o[q] = (half_t)s[q * 33];
                *(half8*)(WT + (size_t)((n0 >> 7) * 256 + which * 128 + (n0 & 127) + n) * D + k0 + 8 * c) = o; }
            __builtin_amdgcn_s_waitcnt(0xc07f); asm volatile("" ::: "memory");
            continue;
        }
        r -= 2 * I_G;
        transpose_item(p.w_down + (size_t)e * DE * D, DE, D, Wd + (size_t)e * D * DE, scr, r, lane, MapId());
    }
}
__device__ void ph_hx(const P& p, int wg, int nwg) {
    const int lane = threadIdx.x & 63, wv = threadIdx.x >> 6, nwv = blockDim.x >> 6;
    const float* mod = (const float*)(p.ws + WS_MOD); half_t* HX = (half_t*)(p.ws + WS_HX);
    for (int row = wg * nwv + wv; row < MR; row += nwg * nwv) {
        const float* src; int mr;
        if (row < M) { src = p.x + (size_t)row * D; mr = row / SEQ; } else { src = p.ctx + (size_t)(row - M) * D; mr = 2; }
        const float* sh = mod + mr * 6144; const float* sc = sh + 1024;
        f32x4 v[4]; float ss = 0.f;
#pragma unroll
        for (int j = 0; j < 4; ++j) { v[j] = ((const f32x4*)src)[lane + 64 * j]; ss += (v[j][0] * v[j][0] + v[j][1] * v[j][1]) + (v[j][2] * v[j][2] + v[j][3] * v[j][3]); }
        ss = wave_sum(ss); const float rstd = 1.0f / sqrtf(ss * (1.0f / D) + RMS_EPS);
#pragma unroll
        for (int j = 0; j < 4; ++j) { const int i0 = 4 * lane + 256 * j;
            const f32x4 g = *(const f32x4*)(p.pre_mix_g + i0), s = *(const f32x4*)(sc + i0), h = *(const f32x4*)(sh + i0);
            half4 o;
#pragma unroll
            for (int q = 0; q < 4; ++q) o[q] = (half_t)(v[j][q] * rstd * g[q] * (1.0f + s[q]) + h[q]);
            *(half4*)(HX + (size_t)row * D + i0) = o; }
    }
}
namespace pg8 {
#define PG8_LAS __attribute__((address_space(3)))
constexpr int BM = 256, BK = 64, HALF = 128, HTB = HALF * BK * 2  , STAGE_BYTES = 8 * HTB, NXCD = 8, WGM = 8;
__host__ __device__ __forceinline__ int lds_byte(int r, int c) { const int st = (r >> 4) * 2 + (c >> 5), rr = r & 15, cc = c & 31, ob = rr * 64 + cc * 2; return st * 1024 + (ob ^ (((ob >> 9) & 1) << 5)); }
__host__ __device__ __forceinline__ void stage_rc(int b, int& R, int& C) { const int st = b / 1024, sb = b % 1024, swz = sb ^ (((sb >> 9) & 1) << 5); R = (st >> 1) * 16 + swz / 64; C = (st & 1) * 32 + (swz % 64) / 2; }
__host__ __device__ __forceinline__ int perm32(int rho) { const int n = rho >> 4, i = rho & 15; return 8 * (i >> 2) + 4 * n + (i & 3); }
struct Unit { int pm, pn, g; };
template <class Epi, class Sched, bool ALIGN_EPI>
__device__ __forceinline__ void gemm_phase(PG8_LAS unsigned char* lds, const int K, const Sched& S, const Epi& E) {
    const int tid = threadIdx.x, wid = __builtin_amdgcn_readfirstlane(tid >> 6), lane = tid & 63, wr = wid >> 2, wc = wid & 3, fr = lane & 15, fq = lane >> 4;
    const int nt = K / BK;
    constexpr bool GA = Sched::GATHER;
    unsigned voffB[2], voffA[2];
#pragma unroll
    for (int i = 0; i < 2; ++i) { int R, C; stage_rc(tid * 16 + i * 8192, R, C); const int Rb = Epi::PERM ? ((R & ~31) + perm32(R & 31)) : R; voffB[i] = (unsigned)(Rb * K + C) * 2u; voffA[i] = (unsigned)(R * K + C) * 2u; }
    const size_t kstep = (size_t)(BK * 2);
    const size_t hstep = (size_t)HALF * K * 2;
    const unsigned ldsw = (unsigned)wid * 1024u;
    const int aoff = lds_byte(wr * 64 + fr, fq * 8), boff = lds_byte(wc * 32 + fr, fq * 8);
#define PG8_SA(b, h) (((b) * 2 + (h)) * HTB)
#define PG8_SB(b, h) ((4 + (b) * 2 + (h)) * HTB)
#define PG8_STAGE(bufoff, gbase, voff) do { _Pragma("unroll") for (int _i = 0; _i < 2; ++_i) \
        __builtin_amdgcn_global_load_lds((const unsigned*)((const char*)(gbase) + (voff)[_i]), (PG8_LAS unsigned*)(lds + (bufoff) + ldsw + _i * 8192), 16, 0, 0); } while (0)
#define PG8_LDA(dst, b, h) do { _Pragma("unroll") for (int m = 0; m < 4; ++m) _Pragma("unroll") for (int k = 0; k < 2; ++k) dst[m][k] = *(const PG8_LAS half8*)(lds + PG8_SA(b, h) + aoff + m * 2048 + k * 1024); } while (0)
#define PG8_LDB(dst, b, h) do { _Pragma("unroll") for (int n = 0; n < 2; ++n) _Pragma("unroll") for (int k = 0; k < 2; ++k) dst[n][k] = *(const PG8_LAS half8*)(lds + PG8_SB(b, h) + boff + n * 2048 + k * 1024); } while (0)
#define PG8_MMA(ai, bj, At, Bt) do { __builtin_amdgcn_s_setprio(1); _Pragma("unroll") for (int m = 0; m < 4; ++m) _Pragma("unroll") for (int n = 0; n < 2; ++n) _Pragma("unroll") for (int k = 0; k < 2; ++k) \
        acc[ai][bj][m][n] = __builtin_amdgcn_mfma_f32_16x16x32_f16(Bt[n][k], At[m][k], acc[ai][bj][m][n], 0, 0, 0); __builtin_amdgcn_s_setprio(0); } while (0)
#define PG8_WAIT_V(n) asm volatile("s_waitcnt vmcnt(" #n ")" ::: "memory")
#define PG8_WAIT_L(n) asm volatile("s_waitcnt lgkmcnt(" #n ")" ::: "memory")
#define PG8_BAR __builtin_amdgcn_s_barrier()
#define PG8_SCHED __builtin_amdgcn_sched_barrier(0)
    Unit cur, nxt; int ui = 0;
    if (!S.next(0, cur)) return;
    f32x4 acc[2][2][4][2];
#pragma unroll
    for (int a = 0; a < 2; ++a)
#pragma unroll
        for (int b = 0; b < 2; ++b)
#pragma unroll
            for (int m = 0; m < 4; ++m)
#pragma unroll
                for (int n = 0; n < 2; ++n) acc[a][b][m][n] = (f32x4){0.f, 0.f, 0.f, 0.f};
    half8 At[4][2], B0[2][2], B1[2][2];
    unsigned vo[2][2], nvo[2][2];
    const size_t hstepA = GA ? (size_t)0 : hstep;
#pragma unroll
    for (int i = 0; i < 2; ++i) { vo[0][i] = voffA[i]; vo[1][i] = voffA[i]; }
    if constexpr (GA) S.a_voff(cur, tid, vo);
    const char* cA = S.a_base(cur); const char* cB = S.b_base(cur);
    PG8_STAGE(PG8_SB(0, 0), cB, voffB); PG8_STAGE(PG8_SB(0, 1), cB + hstep, voffB); PG8_STAGE(PG8_SA(0, 0), cA, vo[0]); PG8_STAGE(PG8_SA(0, 1), cA + hstepA, vo[1]);
    if (wr == 1) PG8_BAR;
    PG8_WAIT_V(2); PG8_BAR;
    PG8_STAGE(PG8_SB(1, 0), cB + kstep, voffB); PG8_STAGE(PG8_SA(1, 0), cA + kstep, vo[0]); PG8_STAGE(PG8_SB(1, 1), cB + hstep + kstep, voffB);
    PG8_WAIT_V(6); PG8_BAR;
    for (;;) {
        const bool has_next = S.next(ui + 1, nxt);
        const char* nA = cA; const char* nB = cB;
        if constexpr (GA) {
#pragma unroll
            for (int h = 0; h < 2; ++h)
#pragma unroll
                for (int i = 0; i < 2; ++i) nvo[h][i] = vo[h][i];
        }
        if (has_next) { nA = S.a_base(nxt); nB = S.b_base(nxt); if constexpr (GA) S.a_voff(nxt, tid, nvo); }
        for (int t = 0; t < nt; t += 2) {
            const bool last = (t == nt - 2);
            const char* a1 = cA + (size_t)(t + 1) * kstep;
            const char* a2 = last ? nA : cA + (size_t)(t + 2) * kstep; const char* b2 = last ? nB : cB + (size_t)(t + 2) * kstep;
            const char* a3 = a2 + kstep; const char* b3 = b2 + kstep;
            unsigned v2[2][2];
#pragma unroll
            for (int h = 0; h < 2; ++h)
#pragma unroll
                for (int i = 0; i < 2; ++i) v2[h][i] = GA ? (last ? nvo[h][i] : vo[h][i]) : voffA[i];
            PG8_LDB(B0, 0, 0); PG8_LDB(B1, 0, 1); PG8_SCHED; PG8_LDA(At, 0, 0); PG8_STAGE(PG8_SA(1, 1), a1 + hstepA, vo[1]);
            PG8_WAIT_V(8); PG8_WAIT_L(0); PG8_BAR; PG8_MMA(0, 0, At, B0); PG8_MMA(0, 1, At, B1); PG8_BAR; PG8_SCHED;
            PG8_LDA(At, 0, 1); PG8_STAGE(PG8_SB(0, 0), b2, voffB); PG8_STAGE(PG8_SB(0, 1), b2 + hstep, voffB); PG8_STAGE(PG8_SA(0, 0), a2, v2[0]);
            PG8_WAIT_V(8); PG8_WAIT_L(0); PG8_BAR; PG8_MMA(1, 0, At, B0); PG8_MMA(1, 1, At, B1); PG8_BAR; PG8_SCHED;
            PG8_LDB(B0, 1, 0); PG8_LDB(B1, 1, 1); PG8_SCHED; PG8_LDA(At, 1, 0); PG8_STAGE(PG8_SA(0, 1), a2 + hstepA, v2[1]);
            PG8_WAIT_V(8); PG8_WAIT_L(0); PG8_BAR; PG8_MMA(0, 0, At, B0); PG8_MMA(0, 1, At, B1); PG8_BAR; PG8_SCHED;
            PG8_LDA(At, 1, 1); PG8_STAGE(PG8_SB(1, 0), b3, voffB); PG8_STAGE(PG8_SB(1, 1), b3 + hstep, voffB); PG8_STAGE(PG8_SA(1, 0), a3, v2[0]);
            PG8_WAIT_V(8); PG8_WAIT_L(0); PG8_BAR; PG8_MMA(1, 0, At, B0); PG8_MMA(1, 1, At, B1); PG8_BAR; PG8_SCHED;
        }
        if constexpr (ALIGN_EPI) { if (wr == 0) PG8_BAR; }
        E(acc, cur, wr, wc, fr, fq);
        if (!has_next) break;
#pragma unroll
        for (int a = 0; a < 2; ++a)
#pragma unroll
            for (int b = 0; b < 2; ++b)
#pragma unroll
                for (int m = 0; m < 4; ++m)
#pragma unroll
                    for (int n = 0; n < 2; ++n) acc[a][b][m][n] = (f32x4){0.f, 0.f, 0.f, 0.f};
        cur = nxt; cA = nA; cB = nB; ++ui;
        if constexpr (GA) {
#pragma unroll
            for (int h = 0; h < 2; ++h)
#pragma unroll
                for (int i = 0; i < 2; ++i) vo[h][i] = nvo[h][i];
        }
        if constexpr (ALIGN_EPI) { if (wr == 1) PG8_BAR; }
    }
    PG8_WAIT_V(0);
    if constexpr (!ALIGN_EPI) { if (wr == 0) PG8_BAR; }
    PG8_BAR;
#undef PG8_SA
#undef PG8_SB
#undef PG8_STAGE
#undef PG8_LDA
#undef PG8_LDB
#undef PG8_MMA
#undef PG8_WAIT_V
#undef PG8_WAIT_L
#undef PG8_BAR
#undef PG8_SCHED
}
}
using pg8::Unit;
__device__ __forceinline__ float fast_silu(float v) { return v * __builtin_amdgcn_rcpf(1.0f + __builtin_amdgcn_exp2f(v * -1.4426950408889634f)); }
__device__ __forceinline__ void static_order_unit(int L, int nM, int nN, int& pm, int& pn) {
    const int nwg = nM * nN; int wgid = L; { const int q = nwg / 8, r = nwg % 8, xcd = wgid % 8, off = wgid / 8; wgid = (xcd < r ? xcd * (q + 1) : r * (q + 1) + (xcd - r) * q) + off; }
    const int nig = 8 * nN, gid = wgid / nig, fm = gid * 8, gsz = (nM - fm) < 8 ? (nM - fm) : 8;
    pm = fm + ((wgid % nig) % gsz); pn = (wgid % nig) / gsz;
}
struct SchedIn {
    static constexpr bool GATHER = false;
    const unsigned char* ws; int G, c;
    __device__ __forceinline__ bool next(int i, Unit& u) const {
        const int L = i * G + c; if (L >= 904) return false; u.g = 0;
        if (L >= 896) { const int r = L - 896; u.pm = 64 + (r >> 2); u.pn = 8 + (r & 3); return true; }
        static_order_unit(L, 64, 14, u.pm, u.pn); return true;
    }
    __device__ __forceinline__ const char* a_base(const Unit& u) const { return (const char*)(ws + WS_HX) + (size_t)u.pm * 256 * D * 2; }
    __device__ __forceinline__ const char* b_base(const Unit& u) const { return (const char*)(ws + WS_WIN) + (size_t)u.pn * 256 * D * 2; }
};
struct EpiIn {
    static constexpr bool PERM = true;
    unsigned char* ws;
    __device__ __forceinline__ void operator()(const f32x4 (&acc)[2][2][4][2], const Unit& u, int wr, int wc, int fr, int fq) const {
        const int sec = u.pn >> 1, row0 = u.pm * 256 + wr * 64 + fr;
        if (sec == 3 || sec == 4) {
            const int cl = wc * 32 + 8 * fq, head = 2 * (u.pn & 1) + (cl >> 6), d0 = cl & 63;
            const float* ct = (const float*)(ws + WS_ROPE); const float* st = (const float*)(ws + WS_ROPE_SIN);
            half_t* base = (half_t*)(ws + (sec == 3 ? WS_Q : WS_K)) + head * 128 + d0;
            const float scl = sec == 4 ? 0.08838834764831845f : 1.0f;
#pragma unroll
            for (int ai = 0; ai < 2; ++ai)
#pragma unroll
                for (int m = 0; m < 4; ++m) {
                    const int row = row0 + ai * 128 + m * 16, pos = row < M ? CTXL + (row & (SEQ - 1)) : (row - M) & (CTXL - 1);
                    const f32x4 c0 = *(const f32x4*)(ct + pos * 64 + d0), c1 = *(const f32x4*)(ct + pos * 64 + d0 + 4), s0 = *(const f32x4*)(st + pos * 64 + d0), s1 = *(const f32x4*)(st + pos * 64 + d0 + 4);
                    half8 o1, o2;
#pragma unroll
                    for (int q = 0; q < 4; ++q) {
                        const float ta = acc[ai][0][m][0][q], tb = acc[ai][1][m][0][q]; o1[q] = (half_t)((ta * c0[q] - tb * s0[q]) * scl); o2[q] = (half_t)((ta * s0[q] + tb * c0[q]) * scl);
                        const float tc = acc[ai][0][m][1][q], td = acc[ai][1][m][1][q]; o1[4 + q] = (half_t)((tc * c1[q] - td * s1[q]) * scl); o2[4 + q] = (half_t)((tc * s1[q] + td * c1[q]) * scl);
                    }
                    *(half8*)(base + (size_t)row * RW) = o1; *(half8*)(base + (size_t)row * RW + 64) = o2;
                }
        } else {
            const size_t off = sec == 0 ? WS_XB : sec == 1 ? WS_XC : sec == 2 ? WS_XX : sec == 5 ? WS_V : WS_G;
            half_t* base = (half_t*)(ws + off) + (u.pn & 1) * 256 + wc * 32 + 8 * fq;
#pragma unroll
            for (int ai = 0; ai < 2; ++ai)
#pragma unroll
                for (int m = 0; m < 4; ++m) {
                    const int row = row0 + ai * 128 + m * 16;
#pragma unroll
                    for (int bj = 0; bj < 2; ++bj) { half8 o;
#pragma unroll
                        for (int q = 0; q < 4; ++q) { o[q] = (half_t)acc[ai][bj][m][0][q]; o[4 + q] = (half_t)acc[ai][bj][m][1][q]; }
                        *(half8*)(base + (size_t)row * CW + bj * 128) = o; }
                }
        }
    }
};
struct SchedOut {
    static constexpr bool GATHER = false;
    const unsigned char* ws; int G, c;
    __device__ __forceinline__ bool next(int i, Unit& u) const { const int L = i * G + c; if (L >= 256) return false; u.g = 0; static_order_unit(L, 64, 4, u.pm, u.pn); return true; }
    __device__ __forceinline__ const char* a_base(const Unit& u) const { return (const char*)(ws + WS_MIXA) + (size_t)u.pm * 256 * D * 2; }
    __device__ __forceinline__ const char* b_base(const Unit& u) const { return (const char*)(ws + WS_WOUT) + (size_t)u.pn * 256 * D * 2; }
};
struct EpiOut {
    static constexpr bool PERM = false;
    float* out;
    __device__ __forceinline__ void operator()(const f32x4 (&acc)[2][2][4][2], const Unit& u, int wr, int wc, int fr, int fq) const {
        const int row0 = u.pm * 256 + wr * 64 + fr, col0 = u.pn * 256 + wc * 32 + 4 * fq;
#pragma unroll
        for (int ai = 0; ai < 2; ++ai)
#pragma unroll
            for (int m = 0; m < 4; ++m) { float* rowp = out + (size_t)(row0 + ai * 128 + m * 16) * D + col0;
#pragma unroll
                for (int bj = 0; bj < 2; ++bj)
#pragma unroll
                    for (int n = 0; n < 2; ++n) *(f32x4*)(rowp + bj * 128 + n * 16) = acc[ai][bj][m][n]; }
    }
};
struct SchedGU {
    static constexpr bool GATHER = true;
    const unsigned char* ws; int G, c;
    __device__ __forceinline__ bool next(int i, Unit& u) const {
        const int L = i * G + c; if (L >= 2048) return false;
        if (G == 256) { const int x = c & 7, l = c >> 3, e = 2 * i + (x >> 2), pm8 = l & 7; u.g = (pm8 >> 2) * NE + e; u.pm = pm8 & 3; u.pn = (x & 3) * 4 + (l >> 3); }
        else { const int e = L >> 7, r = L & 127, pm8 = r & 7; u.g = (pm8 >> 2) * NE + e; u.pm = pm8 & 3; u.pn = r >> 3; }
        return true;
    }
    __device__ __forceinline__ const char* a_base(const Unit& u) const { return (const char*)(ws + WS_HX2); }
    __device__ __forceinline__ const char* b_base(const Unit& u) const { return (const char*)(ws + WS_WGU) + ((size_t)(u.g & 15) * 4096 + (size_t)u.pn * 256) * D * 2; }
    __device__ __forceinline__ void a_voff(const Unit& u, int tid, unsigned (&vo)[2][2]) const {
        const int* idx = (const int*)(ws + WS_IDX) + u.g * CAP + u.pm * 256; const int b = u.g >> 4;
#pragma unroll
        for (int i = 0; i < 2; ++i) { int R, C; pg8::stage_rc(tid * 16 + i * 8192, R, C);
#pragma unroll
            for (int h = 0; h < 2; ++h) vo[h][i] = (unsigned)((b * SEQ + idx[h * 128 + R]) * D + C) * 2u; }
    }
};
struct EpiGU {
    static constexpr bool PERM = true;
    unsigned char* ws;
    __device__ __forceinline__ void operator()(const f32x4 (&acc)[2][2][4][2], const Unit& u, int wr, int wc, int fr, int fq) const {
        half_t* base = (half_t*)(ws + WS_H) + ((size_t)u.g * CAP + u.pm * 256 + wr * 64 + fr) * DE + u.pn * 128 + wc * 32 + 8 * fq;
#pragma unroll
        for (int ai = 0; ai < 2; ++ai)
#pragma unroll
            for (int m = 0; m < 4; ++m) { half8 o;
#pragma unroll
                for (int q = 0; q < 4; ++q) { o[q] = (half_t)(fast_silu(acc[ai][0][m][0][q]) * acc[ai][1][m][0][q]); o[4 + q] = (half_t)(fast_silu(acc[ai][0][m][1][q]) * acc[ai][1][m][1][q]); }
                *(half8*)(base + (size_t)(ai * 128 + m * 16) * DE) = o; }
    }
};
struct SchedDown {
    static constexpr bool GATHER = false;
    const unsigned char* ws; int G, c;
    __device__ __forceinline__ bool next(int i, Unit& u) const {
        const int L = i * G + c; if (L >= 512) return false;
        if (G == 256) { const int x = c & 7, l = c >> 3, e = 8 * i + x, pm8 = l & 7; u.g = (pm8 >> 2) * NE + e; u.pm = pm8 & 3; u.pn = l >> 3; }
        else { const int e = L >> 5, r = L & 31, pm8 = r & 7; u.g = (pm8 >> 2) * NE + e; u.pm = pm8 & 3; u.pn = r >> 3; }
        return true;
    }
    __device__ __forceinline__ const char* a_base(const Unit& u) const { return (const char*)(ws + WS_H) + ((size_t)u.g * CAP + (size_t)u.pm * 256) * DE * 2; }
    __device__ __forceinline__ const char* b_base(const Unit& u) const { return (const char*)(ws + WS_WD) + ((size_t)(u.g & 15) * D + (size_t)u.pn * 256) * DE * 2; }
};
struct EpiDown {
    static constexpr bool PERM = true;
    unsigned char* ws;
    __device__ __forceinline__ void operator()(const f32x4 (&acc)[2][2][4][2], const Unit& u, int wr, int wc, int fr, int fq) const {
        const int slot0 = u.pm * 256 + wr * 64 + fr;
        const float* gate = (const float*)(ws + WS_GATE) + u.g * CAP;
        half_t* base = (half_t*)(ws + WS_Y) + ((size_t)u.g * CAP + slot0) * D + u.pn * 256 + wc * 32 + 8 * fq;
#pragma unroll
        for (int ai = 0; ai < 2; ++ai)
#pragma unroll
            for (int m = 0; m < 4; ++m) { const float gt = gate[slot0 + ai * 128 + m * 16];
#pragma unroll
                for (int bj = 0; bj < 2; ++bj) { half8 o;
#pragma unroll
                    for (int q = 0; q < 4; ++q) { o[q] = (half_t)(acc[ai][bj][m][0][q] * gt); o[4 + q] = (half_t)(acc[ai][bj][m][1][q] * gt); }
                    *(half8*)(base + (size_t)(ai * 128 + m * 16) * D + bj * 128) = o; } }
    }
};
__device__ __forceinline__ unsigned off_b(unsigned row, unsigned ch) { return 256u * row + 16u * (ch ^ (((row & 3u) << 2) | ((row >> 2) & 3u))); }
__device__ __forceinline__ half8 cat4(half4 a, half4 b) { return __builtin_shufflevector(a, b, 0, 1, 2, 3, 4, 5, 6, 7); }
#define TR8(o, a, b) asm volatile("ds_read_b64_tr_b16 %0, %8\n\tds_read_b64_tr_b16 %1, %8 offset:8192\n\tds_read_b64_tr_b16 %2, %8 offset:16384\n\tds_read_b64_tr_b16 %3, %8 offset:24576\n\t" \
    "ds_read_b64_tr_b16 %4, %9\n\tds_read_b64_tr_b16 %5, %9 offset:8192\n\tds_read_b64_tr_b16 %6, %9 offset:16384\n\tds_read_b64_tr_b16 %7, %9 offset:24576\n\t" \
    "s_waitcnt lgkmcnt(0)" : "=&v"(o[0]), "=&v"(o[1]), "=&v"(o[2]), "=&v"(o[3]), "=&v"(o[4]), "=&v"(o[5]), "=&v"(o[6]), "=&v"(o[7]) : "v"(a), "v"(b) : "memory")
struct TrLane { unsigned rowpart[2], X[2], pb, p8; };
__device__ __forceinline__ TrLane tr_lane(int lane) { TrLane t; const unsigned g = lane >> 4, q = (lane & 15) >> 2, p = lane & 3;
    for (unsigned tt = 0; tt < 2; ++tt) { t.rowpart[tt] = 256u * (8u * g + 4u * tt + q); t.X[tt] = (q << 2) | ((2u * g + tt) & 3u); } t.pb = p >> 1; t.p8 = 8u * (p & 1u); return t; }
__device__ __forceinline__ unsigned tr_addr(const TrLane& t, unsigned tile_base, unsigned c, int tt) { return tile_base + t.rowpart[tt] + 16u * ((2u * c + t.pb) ^ t.X[tt]) + t.p8; }
constexpr float LOG2E = 1.4426950408889634f;
__device__ __forceinline__ int chunk_row0(int b, int ch) { return ch < 2 ? M + b * CTXL + ch * 128 : b * SEQ + (ch - 2) * 128; }
__device__ void ph_r1(const P& p, int wg, int nwg, unsigned char* lds) {
    unsigned char* Kf = lds; unsigned char* Kb = lds + 32768; unsigned char* Vt = lds + 65536;
    const unsigned ldsbase = (unsigned)(size_t)lds;
    const half_t* Kg = (const half_t*)(p.ws + WS_K); const half_t* Vg = (const half_t*)(p.ws + WS_V); float* US = (float*)(p.ws + WS_US);
    const int wv = threadIdx.x >> 6;
    for (int it = wg; it < 8 * NCHK; it += nwg) {
        int lane = threadIdx.x & 63; asm volatile("" : "+v"(lane));
        const int tid = wv * 64 + lane, fr = lane & 15, fq = lane >> 4; const TrLane tl = tr_lane(lane);
        const int bh = it / NCHK, ch = it % NCHK, b = bh >> 2, h = bh & 3, row0 = chunk_row0(b, ch);
        const float lgf2 = log_sigmoid_f(p.decay[h]) * LOG2E, lgb2 = log_sigmoid_f(p.decay[4 + h]) * LOG2E;
        __syncthreads();
#pragma unroll
        for (int i = 0; i < 4; ++i) { const int n = tid + 512 * i, r = n >> 4, cn = n & 15;
            const half8 kv = *(const half8*)(Kg + (size_t)(row0 + r) * RW + h * 128 + cn * 8), vv = *(const half8*)(Vg + (size_t)(row0 + r) * RW + h * 128 + cn * 8);
            const float zf = __builtin_amdgcn_exp2f(lgf2 * (float)(127 - r)), zb = __builtin_amdgcn_exp2f(lgb2 * (float)r);
            half8 kf, kb;
#pragma unroll
            for (int q = 0; q < 8; ++q) { kf[q] = (half_t)((float)kv[q] * zf); kb[q] = (half_t)((float)kv[q] * zb); }
            const unsigned o = off_b(r, cn);
            *(half8*)(Kf + o) = kf; *(half8*)(Kb + o) = kb; *(half8*)(Vt + o) = vv; }
        __syncthreads();
        half4 o[8]; half8 Xf[4], Xb[4];
        TR8(o, tr_addr(tl, ldsbase, wv, 0), tr_addr(tl, ldsbase, wv, 1));
#pragma unroll
        for (int ks = 0; ks < 4; ++ks) Xf[ks] = cat4(o[ks], o[4 + ks]);
        TR8(o, tr_addr(tl, ldsbase + 32768u, wv, 0), tr_addr(tl, ldsbase + 32768u, wv, 1));
#pragma unroll
        for (int ks = 0; ks < 4; ++ks) Xb[ks] = cat4(o[ks], o[4 + ks]);
        float* dstf = US + ((size_t)(bh * NCHK + ch) * 2) * 16384 + (16 * wv + fr) * 128 + 4 * fq; float* dstb = dstf + 16384;
#pragma unroll
        for (int et = 0; et < 8; ++et) {
            TR8(o, tr_addr(tl, ldsbase + 65536u, et, 0), tr_addr(tl, ldsbase + 65536u, et, 1));
            f32x4 uf = (f32x4){0.f, 0.f, 0.f, 0.f}, ub = (f32x4){0.f, 0.f, 0.f, 0.f};
#pragma unroll
            for (int ks = 0; ks < 4; ++ks) { const half8 w = cat4(o[ks], o[4 + ks]); uf = __builtin_amdgcn_mfma_f32_16x16x32_f16(w, Xf[ks], uf, 0, 0, 0); ub = __builtin_amdgcn_mfma_f32_16x16x32_f16(w, Xb[ks], ub, 0, 0, 0); }
            *(f32x4*)(dstf + 16 * et) = uf; *(f32x4*)(dstb + 16 * et) = ub;
        }
    }
}
__device__ void ph_scan(const P& p, int wg, int nwg) {
    const float* US = (const float*)(p.ws + WS_US); half_t* SH = (half_t*)(p.ws + WS_SH);
    for (int i = wg * blockDim.x + threadIdx.x; i < 8 * 2 * 4096; i += nwg * blockDim.x) {
        const int el = (i & 4095) * 4, dir = (i >> 12) & 1, bh = i >> 13, h = bh & 3;
        const float g128 = expf(log_sigmoid_f(p.decay[dir * 4 + h]) * 128.0f);
        f32x4 S = (f32x4){0.f, 0.f, 0.f, 0.f};
        for (int s = 0; s < NCHK; ++s) {
            const int ch = dir == 0 ? s : (s == 0 ? 1 : (s == 1 ? 0 : 67 - s));
            const size_t o = ((size_t)(bh * NCHK + ch) * 2 + dir) * 16384 + el;
            const f32x4 u = *(const f32x4*)(US + o);
            half4 sh; sh[0] = (half_t)S[0]; sh[1] = (half_t)S[1]; sh[2] = (half_t)S[2]; sh[3] = (half_t)S[3];
            *(half4*)(SH + o) = sh; S = S * g128 + u;
        }
    }
}
__device__ void ph_r3(const P& p, int wg, int nwg, unsigned char* lds) {
    const int wv = threadIdx.x >> 6;
    unsigned char* Kt = lds; unsigned char* Vt = lds + 32768; unsigned char* St = lds + 65536; unsigned char* Pw = lds + 98304 + wv * 4096;
    const unsigned ldsbase = (unsigned)(size_t)lds;
    const half_t* Qg = (const half_t*)(p.ws + WS_Q); const half_t* Kg = (const half_t*)(p.ws + WS_K); const half_t* Vg = (const half_t*)(p.ws + WS_V); const half_t* Gg = (const half_t*)(p.ws + WS_G);
    const half_t* SH = (const half_t*)(p.ws + WS_SH); half_t* MIXA = (half_t*)(p.ws + WS_MIXA);
    for (int it = wg; it < 8 * 64; it += nwg) {
        int lane = threadIdx.x & 63; asm volatile("" : "+v"(lane));
        const int tid = wv * 64 + lane, fr = lane & 15, fq = lane >> 4; const TrLane tl = tr_lane(lane);
        const int bh = it >> 6, c = it & 63, b = bh >> 2, h = bh & 3, row0 = b * SEQ + c * 128, ch = c + 2, irow = 16 * wv + fr;
        const float lgf2 = log_sigmoid_f(p.decay[h]) * LOG2E, lgb2 = log_sigmoid_f(p.decay[4 + h]) * LOG2E;
        const half_t* Sfg = SH + ((size_t)(bh * NCHK + ch) * 2) * 16384; const half_t* Sbg = Sfg + 16384;
        __syncthreads();
        half8 qf[4];
#pragma unroll
        for (int ks = 0; ks < 4; ++ks) qf[ks] = *(const half8*)(Qg + (size_t)(row0 + irow) * RW + h * 128 + 32 * ks + 8 * fq);
#pragma unroll
        for (int i = 0; i < 4; ++i) { const int n = tid + 512 * i, r = n >> 4, cn = n & 15; const unsigned o = off_b(r, cn);
            *(half8*)(Kt + o) = *(const half8*)(Kg + (size_t)(row0 + r) * RW + h * 128 + cn * 8);
            *(half8*)(Vt + o) = *(const half8*)(Vg + (size_t)(row0 + r) * RW + h * 128 + cn * 8);
            *(half8*)(St + o) = *(const half8*)(Sfg + r * 128 + cn * 8); }
        __syncthreads();
        half8 sbv[4];
#pragma unroll
        for (int i = 0; i < 4; ++i) { const int n = tid + 512 * i; sbv[i] = *(const half8*)(Sbg + (n >> 4) * 128 + (n & 15) * 8); }
        const float xf = __builtin_amdgcn_exp2f(lgf2 * (float)(irow + 1)), xb = __builtin_amdgcn_exp2f(lgb2 * (float)(128 - irow));
#pragma unroll
        for (int jt = 0; jt < 8; ++jt) {
            f32x4 acc = (f32x4){0.f, 0.f, 0.f, 0.f};
#pragma unroll
            for (int ks = 0; ks < 4; ++ks) { const half8 kf = *(const half8*)(Kt + off_b(fr, 4 * ks + fq) + 4096 * jt); acc = __builtin_amdgcn_mfma_f32_16x16x32_f16(kf, qf[ks], acc, 0, 0, 0); }
            half4 ph;
#pragma unroll
            for (int r = 0; r < 4; ++r) { const int dd = irow - (16 * jt + 4 * fq + r); const float m = dd >= 0 ? __builtin_amdgcn_exp2f(lgf2 * (float)dd) : __builtin_amdgcn_exp2f(lgb2 * (float)(-dd)); ph[r] = (half_t)(acc[r] * m); }
            *(half4*)(Pw + off_b(fr, 2 * jt + (fq >> 1)) + 8 * (fq & 1)) = ph;
        }
        f32x4 Y[8]; half4 o[8];
#pragma unroll
        for (int et = 0; et < 8; ++et) {
            TR8(o, tr_addr(tl, ldsbase + 65536u, et, 0), tr_addr(tl, ldsbase + 65536u, et, 1));
            f32x4 acc = (f32x4){0.f, 0.f, 0.f, 0.f};
#pragma unroll
            for (int ks = 0; ks < 4; ++ks) acc = __builtin_amdgcn_mfma_f32_16x16x32_f16(cat4(o[ks], o[4 + ks]), qf[ks], acc, 0, 0, 0);
            Y[et] = acc * xf;
        }
        __syncthreads();
#pragma unroll
        for (int i = 0; i < 4; ++i) { const int n = tid + 512 * i; *(half8*)(Kt + off_b(n >> 4, n & 15)) = sbv[i]; }
        __syncthreads();
        half8 pf[4];
#pragma unroll
        for (int ks = 0; ks < 4; ++ks) pf[ks] = *(const half8*)(Pw + off_b(fr, 4 * ks + fq));
#pragma unroll
        for (int et = 0; et < 8; ++et) {
            TR8(o, tr_addr(tl, ldsbase + 32768u, et, 0), tr_addr(tl, ldsbase + 32768u, et, 1));
#pragma unroll
            for (int ks = 0; ks < 4; ++ks) Y[et] = __builtin_amdgcn_mfma_f32_16x16x32_f16(cat4(o[ks], o[4 + ks]), pf[ks], Y[et], 0, 0, 0);
            TR8(o, tr_addr(tl, ldsbase, et, 0), tr_addr(tl, ldsbase, et, 1));
            f32x4 acc = (f32x4){0.f, 0.f, 0.f, 0.f};
#pragma unroll
            for (int ks = 0; ks < 4; ++ks) acc = __builtin_amdgcn_mfma_f32_16x16x32_f16(cat4(o[ks], o[4 + ks]), qf[ks], acc, 0, 0, 0);
            Y[et] += acc * xb;
        }
        float s = 0.f;
#pragma unroll
        for (int et = 0; et < 8; ++et) s += (Y[et][0] + Y[et][1]) + (Y[et][2] + Y[et][3]);
        s += __shfl_xor(s, 16); s += __shfl_xor(s, 32);
        const float mu = s * (1.0f / 128.0f); float q2 = 0.f;
#pragma unroll
        for (int et = 0; et < 8; ++et) { const f32x4 d4 = Y[et] - mu; q2 += (d4[0] * d4[0] + d4[1] * d4[1]) + (d4[2] * d4[2] + d4[3] * d4[3]); }
        q2 += __shfl_xor(q2, 16); q2 += __shfl_xor(q2, 32);
        const float rstd = 1.0f / sqrtf(q2 * (1.0f / 128.0f) + GN_EPS);
        const half_t* grow = Gg + (size_t)(row0 + irow) * CW + h * 128 + 4 * fq; half_t* orow = MIXA + (size_t)(row0 + irow) * D + CW + h * 128 + 4 * fq; const float* ng = p.ret_norm_g + h * 128 + 4 * fq;
#pragma unroll
        for (int et = 0; et < 8; ++et) { const half4 g4 = *(const half4*)(grow + 16 * et); const f32x4 n4 = *(const f32x4*)(ng + 16 * et); half4 o4;
#pragma unroll
            for (int r = 0; r < 4; ++r) o4[r] = (half_t)(silu_f((float)g4[r]) * ((Y[et][r] - mu) * rstd * n4[r]));
            *(half4*)(orow + 16 * et) = o4; }
    }
}
__device__ void ph_conv(const P& p, int wg, int nwg) {
    const half_t* XB = (const half_t*)(p.ws + WS_XB); const half_t* XC = (const half_t*)(p.ws + WS_XC); const half_t* XX = (const half_t*)(p.ws + WS_XX); half_t* MIXA = (half_t*)(p.ws + WS_MIXA);
    for (int i = wg * blockDim.x + threadIdx.x; i < M * 64; i += nwg * blockDim.x) {
        const int row = i >> 6, ch0 = (i & 63) * 8, n = row & 63;
        const size_t o = (size_t)row * CW + ch0;
        const half8 c1 = *(const half8*)(XC + o), x1 = *(const half8*)(XX + o), bb = *(const half8*)(XB + o);
        half8 c0 = c1, x0 = x1, c2 = c1, x2 = x1;
        if (n != 0) { c0 = *(const half8*)(XC + o - CW); x0 = *(const half8*)(XX + o - CW); }
        if (n != 63) { c2 = *(const half8*)(XC + o + CW); x2 = *(const half8*)(XX + o + CW); }
        half8 r;
#pragma unroll
        for (int q = 0; q < 8; ++q) {
            const float up = n != 0 ? (float)c0[q] * (float)x0[q] : 0.f, u = (float)c1[q] * (float)x1[q], un = n != 63 ? (float)c2[q] * (float)x2[q] : 0.f;
            const float y = up * p.conv_w[ch0 + q] + u * p.conv_w[CW + ch0 + q] + un * p.conv_w[2 * CW + ch0 + q] + p.conv_b[ch0 + q];
            r[q] = (half_t)((float)bb[q] * y);
        }
        *(half8*)(MIXA + (size_t)row * D + ch0) = r;
    }
}
__device__ void ph_postmix(const P& p, int wg, int nwg) {
    const int lane = threadIdx.x & 63, wv = threadIdx.x >> 6, nwv = blockDim.x >> 6;
    const float* mod = (const float*)(p.ws + WS_MOD); half_t* HX2 = (half_t*)(p.ws + WS_HX2); float* AFF = (float*)(p.ws + WS_AFF);
    for (int row = wg * nwv + wv; row < M; row += nwg * nwv) {
        const int b = row / SEQ; const float* mb = mod + b * 6144;
        const float* g1 = mb + 2048; const float* sh2 = mb + 3072; const float* sc2 = mb + 4096;
        f32x4 mx[4], x1[4]; float ss = 0.f;
#pragma unroll
        for (int j = 0; j < 4; ++j) { mx[j] = ((const f32x4*)(p.out + (size_t)row * D))[lane + 64 * j]; ss += (mx[j][0] * mx[j][0] + mx[j][1] * mx[j][1]) + (mx[j][2] * mx[j][2] + mx[j][3] * mx[j][3]); }
        ss = wave_sum(ss); const float r1 = 1.0f / sqrtf(ss * (1.0f / D) + RMS_EPS);
        float s2 = 0.f;
#pragma unroll
        for (int j = 0; j < 4; ++j) { const int i0 = 4 * lane + 256 * j; const f32x4 xv = *(const f32x4*)(p.x + (size_t)row * D + i0), pg = *(const f32x4*)(p.post_mix_g + i0), gg = *(const f32x4*)(g1 + i0);
#pragma unroll
            for (int q = 0; q < 4; ++q) { x1[j][q] = xv[q] + gg[q] * (mx[j][q] * r1 * pg[q]); s2 += x1[j][q] * x1[j][q]; }
            *(f32x4*)(p.out + (size_t)row * D + i0) = x1[j]; }
        s2 = wave_sum(s2); const float r2 = 1.0f / sqrtf(s2 * (1.0f / D) + RMS_EPS);
        float lg[16];
#pragma unroll
        for (int e = 0; e < 16; ++e) lg[e] = 0.f;
#pragma unroll
        for (int j = 0; j < 4; ++j) { const int i0 = 4 * lane + 256 * j; const f32x4 pg = *(const f32x4*)(p.pre_ffn_g + i0), sc = *(const f32x4*)(sc2 + i0), sh = *(const f32x4*)(sh2 + i0);
            half4 o;
#pragma unroll
            for (int q = 0; q < 4; ++q) { const float hv = x1[j][q] * r2 * pg[q] * (1.0f + sc[q]) + sh[q]; o[q] = (half_t)hv;
                const f32x4* wr = (const f32x4*)(p.w_router + (size_t)(i0 + q) * NE);
#pragma unroll
                for (int e4 = 0; e4 < 4; ++e4) { const f32x4 w = wr[e4]; lg[e4 * 4 + 0] += hv * w[0]; lg[e4 * 4 + 1] += hv * w[1]; lg[e4 * 4 + 2] += hv * w[2]; lg[e4 * 4 + 3] += hv * w[3]; } }
            *(half4*)(HX2 + (size_t)row * D + i0) = o; }
        float mxl = -1e30f;
#pragma unroll
        for (int e = 0; e < 16; ++e) { lg[e] = wave_sum(lg[e]) + p.b_router[e]; mxl = fmaxf(mxl, lg[e]); }
        float den = 0.f;
#pragma unroll
        for (int e = 0; e < 16; ++e) { lg[e] = expf(lg[e] - mxl); den += lg[e]; }
        const float inv = 1.0f / den;
        float mine = 0.f;
#pragma unroll
        for (int e = 0; e < 16; ++e) if (lane == e) mine = lg[e] * inv;
        if (lane < 16) AFF[(size_t)row * NE + lane] = mine;
    }
}
__device__ __forceinline__ int block_sum_i(int v, int* red) {
    __syncthreads();
    const int lane = threadIdx.x & 63, wv = threadIdx.x >> 6, nwv = blockDim.x >> 6;
#pragma unroll
    for (int o = 1; o < 64; o <<= 1) v += __shfl_xor(v, o);
    if (lane == 0) red[wv] = v;
    __syncthreads();
    int s = 0; for (int w = 0; w < nwv; ++w) s += red[w];
    return s;
}
__device__ __forceinline__ int block_exscan_i(int v, int* red) {
    __syncthreads();
    const int lane = threadIdx.x & 63, wv = threadIdx.x >> 6, nwv = blockDim.x >> 6;
    int inc = v;
#pragma unroll
    for (int o = 1; o < 64; o <<= 1) { const int t = __shfl_up(inc, o); if (lane >= o) inc += t; }
    if (lane == 63) red[wv] = inc;
    __syncthreads();
    int base = 0; for (int w = 0; w < nwv; ++w) if (w < wv) base += red[w];
    return base + inc - v;
}
__device__ void ph_topk(const P& p, int wg, int nwg, unsigned* lds) {
    unsigned* vals = lds; int* red = (int*)(lds + SEQ);
    const float* AFF = (const float*)(p.ws + WS_AFF); int* IDX = (int*)(p.ws + WS_IDX); float* GATE = (float*)(p.ws + WS_GATE); int* INV = (int*)(p.ws + WS_INV);
    const int tid = threadIdx.x, nthr = blockDim.x, seg = SEQ / nthr;
    for (int it = wg; it < NB * NE; it += nwg) {
        const int b = it / NE, e = it % NE;
        __syncthreads();
        for (int t = tid; t < SEQ; t += nthr) vals[t] = __float_as_uint(AFF[(size_t)(b * SEQ + t) * NE + e]);
        __syncthreads();
        unsigned T = 0u;
        for (int bit = 30; bit >= 0; --bit) {
            const unsigned cand = T | (1u << bit); int cnt = 0;
            for (int t = tid; t < SEQ; t += nthr) cnt += vals[t] >= cand ? 1 : 0;
            if (block_sum_i(cnt, red) >= CAP) T = cand;
        }
        int cgt = 0, ceq = 0;
        for (int t = tid * seg; t < tid * seg + seg; ++t) { cgt += vals[t] > T ? 1 : 0; ceq += vals[t] == T ? 1 : 0; }
        const int tot_gt = block_sum_i(cgt, red), need = CAP - tot_gt;
        const int tie_base = block_exscan_i(ceq, red);
        int nsel = 0, tr = tie_base;
        for (int t = tid * seg; t < tid * seg + seg; ++t) { if (vals[t] > T) ++nsel; else if (vals[t] == T) { if (tr < need) ++nsel; ++tr; } }
        int slot = block_exscan_i(nsel, red); tr = tie_base;
        for (int t = tid * seg; t < tid * seg + seg; ++t) {
            bool sel = false;
            if (vals[t] > T) sel = true; else if (vals[t] == T) { sel = tr < need; ++tr; }
            if (sel) { IDX[it * CAP + slot] = t; GATE[it * CAP + slot] = __uint_as_float(vals[t]); INV[(size_t)(b * SEQ + t) * NE + e] = slot; ++slot; }
            else INV[(size_t)(b * SEQ + t) * NE + e] = -1;
        }
    }
}
__device__ void ph_combine(const P& p, int wg, int nwg) {
    const int lane = threadIdx.x & 63, wv = threadIdx.x >> 6, nwv = blockDim.x >> 6;
    const float* mod = (const float*)(p.ws + WS_MOD); const int* INV = (const int*)(p.ws + WS_INV); const half_t* Y = (const half_t*)(p.ws + WS_Y);
    for (int row = wg * nwv + wv; row < M; row += nwg * nwv) {
        const int b = row / SEQ; const float* g2 = mod + b * 6144 + 5120;
        f32x4 acc[4];
#pragma unroll
        for (int j = 0; j < 4; ++j) acc[j] = (f32x4){0.f, 0.f, 0.f, 0.f};
        for (int e = 0; e < NE; ++e) { const int slot = INV[(size_t)row * NE + e];
            if (slot >= 0) { const half_t* yr = Y + ((size_t)(b * NE + e) * CAP + slot) * D;
#pragma unroll
                for (int j = 0; j < 4; ++j) { const half4 v = *(const half4*)(yr + 4 * lane + 256 * j); acc[j][0] += (float)v[0]; acc[j][1] += (float)v[1]; acc[j][2] += (float)v[2]; acc[j][3] += (float)v[3]; } } }
        float ss = 0.f;
#pragma unroll
        for (int j = 0; j < 4; ++j) ss += (acc[j][0] * acc[j][0] + acc[j][1] * acc[j][1]) + (acc[j][2] * acc[j][2] + acc[j][3] * acc[j][3]);
        ss = wave_sum(ss); const float r = 1.0f / sqrtf(ss * (1.0f / D) + RMS_EPS);
#pragma unroll
        for (int j = 0; j < 4; ++j) { const int i0 = 4 * lane + 256 * j; const f32x4 x1 = *(const f32x4*)(p.out + (size_t)row * D + i0), pg = *(const f32x4*)(p.post_ffn_g + i0), gg = *(const f32x4*)(g2 + i0);
            f32x4 o;
#pragma unroll
            for (int q = 0; q < 4; ++q) o[q] = x1[q] + gg[q] * (acc[j][q] * r * pg[q]);
            *(f32x4*)(p.out + (size_t)row * D + i0) = o; }
    }
}
#define LAS __attribute__((address_space(3)))
#define XB_TMO      128
#define XB_XCNT(j)  (256  + 64 * (j))
#define XB_XSUB(j)  (1280 + 64 * (j))
#define XB_XGEN(j)  (2304 + 64 * (j))
#define XB_TOP      3328
#define XB_TOPGEN   3392
#define XCD_BAR_WORDS 3456
#define XB_SPIN_CAP (1u << 18)
__device__ __forceinline__ unsigned xb_ld(unsigned* p)              { return __hip_atomic_load(p, __ATOMIC_RELAXED, __HIP_MEMORY_SCOPE_AGENT); }
__device__ __forceinline__ unsigned xb_add(unsigned* p, unsigned v) { return __hip_atomic_fetch_add(p, v, __ATOMIC_RELAXED, __HIP_MEMORY_SCOPE_AGENT); }
__device__ __forceinline__ unsigned xb_xcc_id() { return (unsigned)__builtin_amdgcn_s_getreg((3 << 11) | 20) & 0xFu; }
#define XB_SPIN(cond, bar) do { unsigned _sp = 0; while (cond) { __builtin_amdgcn_s_sleep(1); \
    if ((++_sp & 255u) == 0u) { if (xb_ld(&(bar)[XB_TMO])) break; if (_sp > XB_SPIN_CAP) { atomicAdd(&(bar)[XB_TMO], 1u); break; } } } } while (0)
struct XcdBarrier { unsigned* bar; unsigned x; volatile LAS unsigned* st; };
__device__ __forceinline__ XcdBarrier xcd_barrier_post(unsigned* bar, volatile LAS unsigned* st) {
    XcdBarrier b; b.bar = bar; b.x = xb_xcc_id(); b.st = st;
    if (threadIdx.x == 0) (void)xb_add(&bar[XB_XCNT(b.x)], 1u);
    return b;
}
__device__ __forceinline__ void xcd_barrier_complete(unsigned* bar, unsigned x, unsigned& nloc, unsigned& nx) {
    const unsigned G = gridDim.x * gridDim.y * gridDim.z;
    unsigned sum, cnt, mine, sp = 0u;
    for (;;) {
        sum = 0u; cnt = 0u; mine = 0u;
#pragma unroll
        for (unsigned j = 0; j < 16; ++j) { const unsigned c = xb_ld(&bar[XB_XCNT(j)]); sum += c; cnt += (c > 0u) ? 1u : 0u; mine = (j == x) ? c : mine; }
        if (sum == G) break;
        __builtin_amdgcn_s_sleep(1);
        if ((++sp & 255u) == 0u) { if (xb_ld(&bar[XB_TMO])) break; if (sp > XB_SPIN_CAP) { atomicAdd(&bar[XB_TMO], 1u); break; } }
    }
    nloc = mine > 0u ? mine : 1u; nx = cnt > 0u ? cnt : 1u;
}
__device__ __forceinline__ void xcd_barrier(const XcdBarrier& b) {
    asm volatile("s_waitcnt vmcnt(0)" ::: "memory");
    __syncthreads();
    if (threadIdx.x == 0) {
        unsigned* bar = b.bar;
        __builtin_amdgcn_s_waitcnt(0);
        unsigned nloc = b.st[0], nx = b.st[1];
        if (nloc == 0u) { xcd_barrier_complete(bar, b.x, nloc, nx); b.st[0] = nloc; b.st[1] = nx; }
        const unsigned old = xb_add(&bar[XB_XSUB(b.x)], 1u);
        const unsigned gen = old / nloc;
        if (old + 1u == (gen + 1u) * nloc) {
            __builtin_amdgcn_fence(__ATOMIC_RELEASE, "agent");
            asm volatile("s_waitcnt vmcnt(0)" ::: "memory");
            const unsigned og = xb_add(&bar[XB_TOP], 1u);
            const unsigned tg = og / nx;
            if (og + 1u == (tg + 1u) * nx) xb_add(&bar[XB_TOPGEN], 1u);
            else XB_SPIN(xb_ld(&bar[XB_TOPGEN]) == tg, bar);
            __builtin_amdgcn_fence(__ATOMIC_ACQUIRE, "agent");
            xb_add(&bar[XB_XGEN(b.x)], 1u);
            asm volatile("s_waitcnt vmcnt(0)" ::: "memory");
        } else {
            XB_SPIN(xb_ld(&bar[XB_XGEN(b.x)]) == gen, bar);
            __builtin_amdgcn_fence(__ATOMIC_ACQUIRE, "agent");
            asm volatile("s_waitcnt vmcnt(0)" ::: "memory");
        }
    }
    __syncthreads();
}
constexpr int LDS_BYTES = 147456;
constexpr int MISC_OFF = LDS_BYTES - 128;
constexpr size_t CTL_ZERO_BYTES = 65536;
__global__ void __launch_bounds__(512, 2) mega_fwd(P p) {
    extern __shared__ __attribute__((aligned(16))) unsigned char lds[];
    const int wg = blockIdx.x, nwg = gridDim.x;
    volatile LAS unsigned* MISC = (volatile LAS unsigned*)((LAS unsigned char*)lds + MISC_OFF);
    if (threadIdx.x < 32) MISC[threadIdx.x] = 0u;
    __syncthreads();
    const XcdBarrier bar = xcd_barrier_post((unsigned*)(p.ws + WS_CTL) + 4096, MISC + 8);
    ph_mod_partial(p, wg, nwg); ph_rope(p, wg, nwg); ph_prep_weights(p, wg, nwg, (float*)lds);
    xcd_barrier(bar);
    ph_mod_reduce(p, wg, nwg);
    xcd_barrier(bar);
    ph_hx(p, wg, nwg);
    xcd_barrier(bar);
    { const SchedIn S{p.ws, nwg, wg}; const EpiIn E{p.ws}; pg8::gemm_phase<EpiIn, SchedIn, true>((PG8_LAS unsigned char*)lds, D, S, E); }
    xcd_barrier(bar);
    ph_r1(p, wg, nwg, lds); ph_conv(p, wg, nwg);
    xcd_barrier(bar);
    ph_scan(p, wg, nwg);
    xcd_barrier(bar);
    ph_r3(p, wg, nwg, lds);
    xcd_barrier(bar);
    { const SchedOut S{p.ws, nwg, wg}; const EpiOut E{p.out}; pg8::gemm_phase<EpiOut, SchedOut, false>((PG8_LAS unsigned char*)lds, D, S, E); }
    xcd_barrier(bar);
    ph_postmix(p, wg, nwg);
    xcd_barrier(bar);
    ph_topk(p, wg, nwg, (unsigned*)lds);
    xcd_barrier(bar);
    { const SchedGU S{p.ws, nwg, wg}; const EpiGU E{p.ws}; pg8::gemm_phase<EpiGU, SchedGU, true>((PG8_LAS unsigned char*)lds, D, S, E); }
    xcd_barrier(bar);
    { const SchedDown S{p.ws, nwg, wg}; const EpiDown E{p.ws}; pg8::gemm_phase<EpiDown, SchedDown, true>((PG8_LAS unsigned char*)lds, DE, S, E); }
    xcd_barrier(bar);
    ph_combine(p, wg, nwg);
}

extern "C" void kernel_launch(void* const* d_in, const int* in_sizes, int n_in, void* d_out, int out_size, void* d_ws, size_t ws_size, hipStream_t stream) {
    static int grid = 0;
    if (grid == 0) {
        if (n_in != 21 || ws_size < WS_END || out_size != M * D) { fprintf(stderr, "kernel_launch: unexpected shapes n_in %d ws %zu out %d\n", n_in, ws_size, out_size); grid = -1; return; }
        int dev = 0, cus = 0, per_cu = 0;
        if (hipGetDevice(&dev) != hipSuccess || hipDeviceGetAttribute(&cus, hipDeviceAttributeMultiprocessorCount, dev) != hipSuccess) { grid = -1; return; }
        if (hipFuncSetAttribute((const void*)mega_fwd, hipFuncAttributeMaxDynamicSharedMemorySize, LDS_BYTES) != hipSuccess) { fprintf(stderr, "kernel_launch: hipFuncSetAttribute failed\n"); grid = -1; return; }
        if (hipOccupancyMaxActiveBlocksPerMultiprocessor(&per_cu, (const void*)mega_fwd, 512, LDS_BYTES) != hipSuccess || per_cu < 1) { fprintf(stderr, "kernel_launch: occupancy query says %d\n", per_cu); (void)hipGetLastError(); per_cu = 1; }
        grid = cus;
    }
    if (grid < 0) return;
    if (hipMemsetAsync((char*)d_ws + WS_CTL, 0, CTL_ZERO_BYTES, stream) != hipSuccess) return;
    P p{};
    const float** f = (const float**)&p;
    for (int i = 0; i < 21; ++i) f[i] = (const float*)d_in[i];
    p.out = (float*)d_out; p.ws = (unsigned char*)d_ws;
    hipLaunchKernelGGL(mega_fwd, dim3(grid), dim3(512), LDS_BYTES, stream, p);
}
```

```cpp
#include <hip/hip_runtime.h>
#include <cstdint>
#include <cstdio>

typedef _Float16 half_t;
typedef _Float16 half8 __attribute__((ext_vector_type(8)));
typedef _Float16 half4 __attribute__((ext_vector_type(4)));
typedef float f32x4 __attribute__((ext_vector_type(4)));
#define LAS __attribute__((address_space(3)))

constexpr int D = 1024, NB = 2, SEQ = 8192, M = NB * SEQ, CTXL = 256, MC = NB * CTXL, MR = M + MC;
constexpr int CW = 512, NH = 4, HD = 128, RW = 512, INC = 3584;
constexpr int NCHK = 66;
constexpr int NE = 16, CAP = 1024, DE = 2048;
constexpr float RMS_EPS = 1e-6f, GN_EPS = 1e-6f;

constexpr size_t MiB = 1u << 20;
constexpr size_t WS_CTL = 0;
constexpr size_t WS_MODP = 1 * MiB;
constexpr size_t WS_MOD = 3 * MiB;
constexpr size_t WS_ROPE = 4 * MiB;
constexpr size_t WS_ROPE_SIN = WS_ROPE + 2560 * 1024;
constexpr size_t WS_AFF = 9 * MiB;
constexpr size_t WS_IDX = 10 * MiB;
constexpr size_t WS_GATE = WS_IDX + 256 * 1024;
constexpr size_t WS_INV = 11 * MiB;
constexpr size_t WS_WIN = 12 * MiB;
constexpr size_t WS_WOUT = 19 * MiB;
constexpr size_t WS_WGU = 21 * MiB;
constexpr size_t WS_WD = 149 * MiB;
constexpr size_t WS_A = 213 * MiB;
constexpr size_t WS_HX = WS_A, WS_MIXA = WS_A + 33 * MiB, WS_HX2 = WS_A, WS_Y = WS_A;
constexpr size_t WS_SH = WS_A;
constexpr size_t WS_B = 279 * MiB;
constexpr size_t WS_XB = WS_B, WS_XC = WS_B + 16 * MiB, WS_XX = WS_B + 32 * MiB, WS_G = WS_B + 48 * MiB;
constexpr size_t WS_Q = WS_B + 64 * MiB, WS_K = WS_Q + 17 * MiB, WS_V = WS_K + 17 * MiB;
constexpr size_t WS_US = WS_V + 17 * MiB;
constexpr size_t WS_H = WS_B;
constexpr size_t WS_END = WS_US + 66 * MiB;
static_assert(WS_H + 128 * MiB <= WS_END, "H overlay");

struct P {
    const float *x, *c, *ctx, *c_ctx, *w_ada, *b_ada, *pre_mix_g, *post_mix_g, *pre_ffn_g, *post_ffn_g, *w_in, *conv_w, *conv_b, *decay, *ret_norm_g, *w_out,
        *w_router, *b_router, *w_gate, *w_up, *w_down;
    float* out; unsigned char* ws;
};

__device__ __forceinline__ float wave_sum(float v) {
#pragma unroll
    for (int o = 1; o < 64; o <<= 1) v += __shfl_xor(v, o);
    return v;
}
__device__ __forceinline__ float silu_f(float v) { return v / (1.0f + expf(-v)); }
__device__ __forceinline__ float log_sigmoid_f(float v) { return v >= 0.f ? -log1pf(expf(-v)) : v - log1pf(expf(v)); }

__host__ __device__ __forceinline__ int in_col_src(int R) {
    if (R < 1536 || R >= 2560) return R;
    const int sec_base = R < 2048 ? 1536 : 2048, r = R - sec_base, t = r >> 8, c = r & 255, hi = c >> 7, cc = c & 127;
    return sec_base + (2 * t + (cc >> 6)) * 128 + hi * 64 + (cc & 63);
}

__device__ void ph_mod_partial(const P& p, int wg, int nwg) {
    const int sub = threadIdx.x >> 8, nsub = blockDim.x >> 8, t = threadIdx.x & 255;
    float* part = (float*)(p.ws + WS_MODP);
    for (int it = wg * nsub + sub; it < 24 * 16; it += nwg * nsub) {
        const int cb = it % 24, ks = it / 24, col = cb * 256 + t;
        float a0 = 0.f, a1 = 0.f, a2 = 0.f;
        for (int k = ks * 64; k < ks * 64 + 64; ++k) {
            const float w = p.w_ada[(size_t)k * 6144 + col];
            a0 += silu_f(p.c[k]) * w; a1 += silu_f(p.c[1024 + k]) * w; a2 += silu_f(p.c_ctx[k]) * w;
        }
        part[(ks * 3 + 0) * 6144 + col] = a0; part[(ks * 3 + 1) * 6144 + col] = a1; part[(ks * 3 + 2) * 6144 + col] = a2;
    }
}
__device__ void ph_rope(const P& p, int wg, int nwg) {
    float* ct = (float*)(p.ws + WS_ROPE); float* st = (float*)(p.ws + WS_ROPE_SIN);
    for (int i = wg * blockDim.x + threadIdx.x; i < 8448 * 64; i += nwg * blockDim.x) {
        const int pos = i >> 6, j = i & 63;
        const float inv = 1.0f / powf(10000.0f, (float)j / 64.0f);
        const float ang = (float)pos * inv;
        const double a = (double)ang; const double kk = rint(a * 0.15915494309189535); const double r = a - kk * 6.283185307179586476925;
        ct[i] = (float)cos(r); st[i] = (float)sin(r);
    }
}
template <class Map>
__device__ __forceinline__ void transpose_item(const float* W, int K, int N, half_t* WT, float* scr, int item, int lane, Map srcmap) {
    const int nblk = N / 32, kb = item / nblk, nb = item % nblk, k0 = 64 * kb, n0 = 32 * nb;
    const int scol = srcmap(n0 + (lane & 31));
#pragma unroll 8
    for (int i = 0; i < 32; ++i) { const int kk = 2 * i + (lane >> 5); scr[kk * 33 + (lane & 31)] = W[(size_t)(k0 + kk) * N + scol]; }
    __builtin_amdgcn_s_waitcnt(0xc07f); asm volatile("" ::: "memory");
    const int c = lane & 7;
#pragma unroll
    for (int j = 0; j < 4; ++j) { const int n = (lane >> 3) + 8 * j; const float* s = scr + (8 * c) * 33 + n;
        half8 o;
#pragma unroll
        for (int q = 0; q < 8; ++q) o[q] = (half_t)s[q * 33];
        *(half8*)(WT + (size_t)(n0 + n) * K + k0 + 8 * c) = o; }
    __builtin_amdgcn_s_waitcnt(0xc07f); asm volatile("" ::: "memory");
}
struct MapId { __device__ int operator()(int R) const { return R; } };
struct MapIn { __device__ int operator()(int R) const { return in_col_src(R); } };
__device__ void ph_prep_weights(const P& p, int wg, int nwg, float* lds_f) {
    const int lane = threadIdx.x & 63, wv = threadIdx.x >> 6, nwv = blockDim.x >> 6;
    float* scr = lds_f + wv * (64 * 33);
    half_t* Win = (half_t*)(p.ws + WS_WIN); half_t* Wout = (half_t*)(p.ws + WS_WOUT); half_t* Wgu = (half_t*)(p.ws + WS_WGU); half_t* Wd = (half_t*)(p.ws + WS_WD);
    constexpr int I_IN = (D / 64) * (INC / 32), I_OUT = (D / 64) * (D / 32), I_G = (D / 64) * (DE / 32), I_D = (DE / 64) * (D / 32);
    constexpr int NIT = I_IN + I_OUT + NE * (2 * I_G + I_D);
    for (int it = wg * nwv + wv; it < NIT; it += nwg * nwv) {
        int r = it;
        if (r < I_IN) { transpose_item(p.w_in, D, INC, Win, scr, r, lane, MapIn()); continue; } r -= I_IN;
        if (r < I_OUT) { transpose_item(p.w_out, D, D, Wout, scr, r, lane, MapId()); continue; } r -= I_OUT;
        const int e = r / (2 * I_G + I_D); r -= e * (2 * I_G + I_D);
        if (r < 2 * I_G) {
            const int which = r / I_G, item = r % I_G;
            const float* W = (which ? p.w_up : p.w_gate) + (size_t)e * D * DE;
            const int nblk = DE / 32, kb = item / nblk, nb = item % nblk, k0 = 64 * kb, n0 = 32 * nb;
            half_t* WT = Wgu + (size_t)e * 4096 * D;
#pragma unroll 8
            for (int i = 0; i < 32; ++i) { const int kk = 2 * i + (lane >> 5); scr[kk * 33 + (lane & 31)] = W[(size_t)(k0 + kk) * DE + n0 + (lane & 31)]; }
            __builtin_amdgcn_s_waitcnt(0xc07f); asm volatile("" ::: "memory");
            const int c = lane & 7;
#pragma unroll
            for (int j = 0; j < 4; ++j) { const int n = (lane >> 3) + 8 * j; const float* s = scr + (8 * c) * 33 + n;
                half8 o;
#pragma unroll
                for (int q = 0; q < 8; ++q) o[q] = (half_t)s[q * 33];
                *(half8*)(WT + (size_t)((n0 >> 7) * 256 + which * 128 + (n0 & 127) + n) * D + k0 + 8 * c) = o; }
            __builtin_amdgcn_s_waitcnt(0xc07f); asm volatile("" ::: "memory");
            continue;
        }
        r -= 2 * I_G;
        transpose_item(p.w_down + (size_t)e * DE * D, DE, D, Wd + (size_t)e * D * DE, scr, r, lane, MapId());
    }
}
__device__ void ph_hx(const P& p, int wg, int nwg, float* lds) {
    const int tid = threadIdx.x, nthr = blockDim.x, lane = tid & 63, wv = tid >> 6;
    const float* part = (const float*)(p.ws + WS_MODP); float* mod = (float*)(p.ws + WS_MOD); half_t* HX = (half_t*)(p.ws + WS_HX);
    for (int i = wg * nthr + tid; i < 3 * 6144; i += nwg * nthr) {
        float s = p.b_ada[i % 6144];
        for (int ks = 0; ks < 16; ++ks) s += part[ks * 3 * 6144 + i];
        mod[i] = s;
    }
    float* sv = lds;
    for (int blk = wg; blk < 264; blk += nwg) {
        const int mr = blk < 256 ? (blk >> 7) : 2, base = blk < 256 ? blk * 64 : M + (blk - 256) * 64;
        __syncthreads();
        for (int i = tid; i < 2048; i += nthr) { float s = p.b_ada[i];
            for (int ks = 0; ks < 16; ++ks) s += part[(ks * 3 + mr) * 6144 + i];
            sv[i] = s; }
        __syncthreads();
        for (int rr = 0; rr < 8; rr += 2) {
            const int row = base + wv * 8 + rr;
            const float* s0 = row < M ? p.x + (size_t)row * D : p.ctx + (size_t)(row - M) * D; const float* s1 = s0 + D;
            f32x4 v0[4], v1[4]; float a0 = 0.f, a1 = 0.f;
#pragma unroll
            for (int j = 0; j < 4; ++j) { v0[j] = ((const f32x4*)s0)[lane + 64 * j]; v1[j] = ((const f32x4*)s1)[lane + 64 * j]; }
#pragma unroll
            for (int j = 0; j < 4; ++j) { a0 += (v0[j][0] * v0[j][0] + v0[j][1] * v0[j][1]) + (v0[j][2] * v0[j][2] + v0[j][3] * v0[j][3]); a1 += (v1[j][0] * v1[j][0] + v1[j][1] * v1[j][1]) + (v1[j][2] * v1[j][2] + v1[j][3] * v1[j][3]); }
            a0 = wave_sum(a0); a1 = wave_sum(a1);
            const float r0 = 1.0f / sqrtf(a0 * (1.0f / D) + RMS_EPS), r1 = 1.0f / sqrtf(a1 * (1.0f / D) + RMS_EPS);
#pragma unroll
            for (int j = 0; j < 4; ++j) { const int i0 = 4 * lane + 256 * j;
                const f32x4 g = *(const f32x4*)(p.pre_mix_g + i0), h = *(const f32x4*)(sv + i0), s = *(const f32x4*)(sv + 1024 + i0);
                half4 o0, o1;
#pragma unroll
                for (int q = 0; q < 4; ++q) { const float gs = g[q] * (1.0f + s[q]); o0[q] = (half_t)(v0[j][q] * r0 * gs + h[q]); o1[q] = (half_t)(v1[j][q] * r1 * gs + h[q]); }
                *(half4*)(HX + (size_t)row * D + i0) = o0; *(half4*)(HX + (size_t)(row + 1) * D + i0) = o1; }
        }
    }
}
namespace pg8 {
#define PG8_LAS __attribute__((address_space(3)))
constexpr int BM = 256, BK = 64, HALF = 128, HTB = HALF * BK * 2  , STAGE_BYTES = 8 * HTB, NXCD = 8, WGM = 8;
__host__ __device__ __forceinline__ int lds_byte(int r, int c) { const int st = (r >> 4) * 2 + (c >> 5), rr = r & 15, cc = c & 31, ob = rr * 64 + cc * 2; return st * 1024 + (ob ^ (((ob >> 9) & 1) << 5)); }
__host__ __device__ __forceinline__ void stage_rc(int b, int& R, int& C) { const int st = b / 1024, sb = b % 1024, swz = sb ^ (((sb >> 9) & 1) << 5); R = (st >> 1) * 16 + swz / 64; C = (st & 1) * 32 + (swz % 64) / 2; }
__host__ __device__ __forceinline__ int perm32(int rho) { const int n = rho >> 4, i = rho & 15; return 8 * (i >> 2) + 4 * n + (i & 3); }
struct Unit { int pm, pn, g; };
template <class Epi, class Sched, bool ALIGN_EPI>
__device__ __forceinline__ void gemm_phase(PG8_LAS unsigned char* lds, const int K, const Sched& S, const Epi& E) {
    int tid = threadIdx.x; asm volatile("" : "+v"(tid));
    const int wid = __builtin_amdgcn_readfirstlane(tid >> 6), lane = tid & 63, wr = wid >> 2, wc = wid & 3, fr = lane & 15, fq = lane >> 4;
    const int nt = K / BK;
    constexpr bool GA = Sched::GATHER;
    unsigned voffB[2], voffA[2];
#pragma unroll
    for (int i = 0; i < 2; ++i) { int R, C; stage_rc(tid * 16 + i * 8192, R, C); const int Rb = Epi::PERM ? ((R & ~31) + perm32(R & 31)) : R; voffB[i] = (unsigned)(Rb * K + C) * 2u; voffA[i] = (unsigned)(R * K + C) * 2u; }
    const size_t kstep = (size_t)(BK * 2);
    const size_t hstep = (size_t)HALF * K * 2;
    const unsigned ldsw = (unsigned)wid * 1024u;
    const int aoff = lds_byte(wr * 64 + fr, fq * 8), boff = lds_byte(wc * 32 + fr, fq * 8);
#define PG8_SA(b, h) (((b) * 2 + (h)) * HTB)
#define PG8_SB(b, h) ((4 + (b) * 2 + (h)) * HTB)
#define PG8_STAGE(bufoff, gbase, voff) do { _Pragma("unroll") for (int _i = 0; _i < 2; ++_i) \
        __builtin_amdgcn_global_load_lds((const unsigned*)((const char*)(gbase) + (voff)[_i]), (PG8_LAS unsigned*)(lds + (bufoff) + ldsw + _i * 8192), 16, 0, 0); } while (0)
#define PG8_LDA(dst, b, h) do { _Pragma("unroll") for (int m = 0; m < 4; ++m) _Pragma("unroll") for (int k = 0; k < 2; ++k) dst[m][k] = *(const PG8_LAS half8*)(lds + PG8_SA(b, h) + aoff + m * 2048 + k * 1024); } while (0)
#define PG8_LDB(dst, b, h) do { _Pragma("unroll") for (int n = 0; n < 2; ++n) _Pragma("unroll") for (int k = 0; k < 2; ++k) dst[n][k] = *(const PG8_LAS half8*)(lds + PG8_SB(b, h) + boff + n * 2048 + k * 1024); } while (0)
#define PG8_MMA(ai, bj, At, Bt) do { __builtin_amdgcn_s_setprio(1); _Pragma("unroll") for (int m = 0; m < 4; ++m) _Pragma("unroll") for (int n = 0; n < 2; ++n) _Pragma("unroll") for (int k = 0; k < 2; ++k) \
        acc[ai][bj][m][n] = __builtin_amdgcn_mfma_f32_16x16x32_f16(Bt[n][k], At[m][k], acc[ai][bj][m][n], 0, 0, 0); __builtin_amdgcn_s_setprio(0); } while (0)
#define PG8_WAIT_V(n) asm volatile("s_waitcnt vmcnt(" #n ")" ::: "memory")
#define PG8_WAIT_L(n) asm volatile("s_waitcnt lgkmcnt(" #n ")" ::: "memory")
#define PG8_BAR __builtin_amdgcn_s_barrier()
#define PG8_SCHED __builtin_amdgcn_sched_barrier(0)
    Unit cur, nxt; int ui = 0;
    if (!S.next(0, cur)) return;
    f32x4 acc[2][2][4][2];
#pragma unroll
    for (int a = 0; a < 2; ++a)
#pragma unroll
        for (int b = 0; b < 2; ++b)
#pragma unroll
            for (int m = 0; m < 4; ++m)
#pragma unroll
                for (int n = 0; n < 2; ++n) acc[a][b][m][n] = (f32x4){0.f, 0.f, 0.f, 0.f};
    half8 At[4][2], B0[2][2], B1[2][2];
    unsigned vo[2][2], nvo[2][2];
    const size_t hstepA = GA ? (size_t)0 : hstep;
#pragma unroll
    for (int i = 0; i < 2; ++i) { vo[0][i] = voffA[i]; vo[1][i] = voffA[i]; }
    if constexpr (GA) S.a_voff(cur, tid, vo);
    const char* cA = S.a_base(cur); const char* cB = S.b_base(cur);
    PG8_STAGE(PG8_SB(0, 0), cB, voffB); PG8_STAGE(PG8_SB(0, 1), cB + hstep, voffB); PG8_STAGE(PG8_SA(0, 0), cA, vo[0]); PG8_STAGE(PG8_SA(0, 1), cA + hstepA, vo[1]);
    if (wr == 1) PG8_BAR;
    PG8_WAIT_V(2); PG8_BAR;
    PG8_STAGE(PG8_SB(1, 0), cB + kstep, voffB); PG8_STAGE(PG8_SA(1, 0), cA + kstep, vo[0]); PG8_STAGE(PG8_SB(1, 1), cB + hstep + kstep, voffB);
    PG8_WAIT_V(6); PG8_BAR;
    for (;;) {
        const bool has_next = S.next(ui + 1, nxt);
        const char* nA = cA; const char* nB = cB;
        if constexpr (GA) {
#pragma unroll
            for (int h = 0; h < 2; ++h)
#pragma unroll
                for (int i = 0; i < 2; ++i) nvo[h][i] = vo[h][i];
        }
        if (has_next) { nA = S.a_base(nxt); nB = S.b_base(nxt); if constexpr (GA) S.a_voff(nxt, tid, nvo); }
        for (int t = 0; t < nt; t += 2) {
            const bool last = (t == nt - 2);
            const char* a1 = cA + (size_t)(t + 1) * kstep;
            const char* a2 = last ? nA : cA + (size_t)(t + 2) * kstep; const char* b2 = last ? nB : cB + (size_t)(t + 2) * kstep;
            const char* a3 = a2 + kstep; const char* b3 = b2 + kstep;
            unsigned v2[2][2];
#pragma unroll
            for (int h = 0; h < 2; ++h)
#pragma unroll
                for (int i = 0; i < 2; ++i) v2[h][i] = GA ? (last ? nvo[h][i] : vo[h][i]) : voffA[i];
            PG8_LDB(B0, 0, 0); PG8_LDB(B1, 0, 1); PG8_SCHED; PG8_LDA(At, 0, 0); PG8_STAGE(PG8_SA(1, 1), a1 + hstepA, vo[1]);
            PG8_WAIT_V(8); PG8_WAIT_L(0); PG8_BAR; PG8_MMA(0, 0, At, B0); PG8_MMA(0, 1, At, B1); PG8_BAR; PG8_SCHED;
            PG8_LDA(At, 0, 1); PG8_STAGE(PG8_SB(0, 0), b2, voffB); PG8_STAGE(PG8_SB(0, 1), b2 + hstep, voffB); PG8_STAGE(PG8_SA(0, 0), a2, v2[0]);
            PG8_WAIT_V(8); PG8_WAIT_L(0); PG8_BAR; PG8_MMA(1, 0, At, B0); PG8_MMA(1, 1, At, B1); PG8_BAR; PG8_SCHED;
            PG8_LDB(B0, 1, 0); PG8_LDB(B1, 1, 1); PG8_SCHED; PG8_LDA(At, 1, 0); PG8_STAGE(PG8_SA(0, 1), a2 + hstepA, v2[1]);
            PG8_WAIT_V(8); PG8_WAIT_L(0); PG8_BAR; PG8_MMA(0, 0, At, B0); PG8_MMA(0, 1, At, B1); PG8_BAR; PG8_SCHED;
            PG8_LDA(At, 1, 1); PG8_STAGE(PG8_SB(1, 0), b3, voffB); PG8_STAGE(PG8_SB(1, 1), b3 + hstep, voffB); PG8_STAGE(PG8_SA(1, 0), a3, v2[0]);
            PG8_WAIT_V(8); PG8_WAIT_L(0); PG8_BAR; PG8_MMA(1, 0, At, B0); PG8_MMA(1, 1, At, B1); PG8_BAR; PG8_SCHED;
        }
        if constexpr (ALIGN_EPI) { if (wr == 0) PG8_BAR; }
        E(acc, cur, wr, wc, fr, fq);
        if (!has_next) break;
#pragma unroll
        for (int a = 0; a < 2; ++a)
#pragma unroll
            for (int b = 0; b < 2; ++b)
#pragma unroll
                for (int m = 0; m < 4; ++m)
#pragma unroll
                    for (int n = 0; n < 2; ++n) acc[a][b][m][n] = (f32x4){0.f, 0.f, 0.f, 0.f};
        cur = nxt; cA = nA; cB = nB; ++ui;
        if constexpr (GA) {
#pragma unroll
            for (int h = 0; h < 2; ++h)
#pragma unroll
                for (int i = 0; i < 2; ++i) vo[h][i] = nvo[h][i];
        }
        if constexpr (ALIGN_EPI) { if (wr == 1) PG8_BAR; }
    }
    PG8_WAIT_V(0);
    if constexpr (!ALIGN_EPI) { if (wr == 0) PG8_BAR; }
    PG8_BAR;
#undef PG8_SA
#undef PG8_SB
#undef PG8_STAGE
#undef PG8_LDA
#undef PG8_LDB
#undef PG8_MMA
#undef PG8_WAIT_V
#undef PG8_WAIT_L
#undef PG8_BAR
#undef PG8_SCHED
}
}
using pg8::Unit;
__device__ __forceinline__ float fast_silu(float v) { return v * __builtin_amdgcn_rcpf(1.0f + __builtin_amdgcn_exp2f(v * -1.4426950408889634f)); }
__device__ __forceinline__ void static_order_unit(int L, int nM, int nN, int& pm, int& pn) {
    const int nwg = nM * nN; int wgid = L; { const int q = nwg / 8, r = nwg % 8, xcd = wgid % 8, off = wgid / 8; wgid = (xcd < r ? xcd * (q + 1) : r * (q + 1) + (xcd - r) * q) + off; }
    const int nig = 8 * nN, gid = wgid / nig, fm = gid * 8, gsz = (nM - fm) < 8 ? (nM - fm) : 8;
    pm = fm + ((wgid % nig) % gsz); pn = (wgid % nig) / gsz;
}
struct SchedIn {
    static constexpr bool GATHER = false;
    const unsigned char* ws; int G, c;
    __device__ __forceinline__ bool next(int i, Unit& u) const {
        const int L = i * G + c; if (L >= 904) return false; u.g = 0;
        if (L >= 896) { const int r = L - 896; u.pm = 64 + (r >> 2); u.pn = 8 + (r & 3); return true; }
        static_order_unit(L, 64, 14, u.pm, u.pn); return true;
    }
    __device__ __forceinline__ const char* a_base(const Unit& u) const { return (const char*)(ws + WS_HX) + (size_t)u.pm * 256 * D * 2; }
    __device__ __forceinline__ const char* b_base(const Unit& u) const { return (const char*)(ws + WS_WIN) + (size_t)u.pn * 256 * D * 2; }
};
struct EpiIn {
    static constexpr bool PERM = true;
    unsigned char* ws;
    __device__ __forceinline__ void operator()(const f32x4 (&acc)[2][2][4][2], const Unit& u, int wr, int wc, int fr, int fq) const {
        const int sec = u.pn >> 1, row0 = u.pm * 256 + wr * 64 + fr;
        if (sec == 3 || sec == 4) {
            const int cl = wc * 32 + 8 * fq, head = 2 * (u.pn & 1) + (cl >> 6), d0 = cl & 63;
            const float* ct = (const float*)(ws + WS_ROPE); const float* st = (const float*)(ws + WS_ROPE_SIN);
            half_t* base = (half_t*)(ws + (sec == 3 ? WS_Q : WS_K)) + head * 128 + d0;
            const float scl = sec == 4 ? 0.08838834764831845f : 1.0f;
#pragma unroll
            for (int ai = 0; ai < 2; ++ai)
#pragma unroll
                for (int m = 0; m < 4; ++m) {
                    const int row = row0 + ai * 128 + m * 16, pos = row < M ? CTXL + (row & (SEQ - 1)) : (row - M) & (CTXL - 1);
                    const f32x4 c0 = *(const f32x4*)(ct + pos * 64 + d0), c1 = *(const f32x4*)(ct + pos * 64 + d0 + 4), s0 = *(const f32x4*)(st + pos * 64 + d0), s1 = *(const f32x4*)(st + pos * 64 + d0 + 4);
                    half8 o1, o2;
#pragma unroll
                    for (int q = 0; q < 4; ++q) {
                        const float ta = acc[ai][0][m][0][q], tb = acc[ai][1][m][0][q]; o1[q] = (half_t)((ta * c0[q] - tb * s0[q]) * scl); o2[q] = (half_t)((ta * s0[q] + tb * c0[q]) * scl);
                        const float tc = acc[ai][0][m][1][q], td = acc[ai][1][m][1][q]; o1[4 + q] = (half_t)((tc * c1[q] - td * s1[q]) * scl); o2[4 + q] = (half_t)((tc * s1[q] + td * c1[q]) * scl);
                    }
                    *(half8*)(base + (size_t)row * RW) = o1; *(half8*)(base + (size_t)row * RW + 64) = o2;
                    asm volatile("" ::: "memory");
                }
        } else {
            const size_t off = sec == 0 ? WS_XB : sec == 1 ? WS_XC : sec == 2 ? WS_XX : sec == 5 ? WS_V : WS_G;
            half_t* base = (half_t*)(ws + off) + (u.pn & 1) * 256 + wc * 32 + 8 * fq;
#pragma unroll
            for (int ai = 0; ai < 2; ++ai)
#pragma unroll
                for (int m = 0; m < 4; ++m) {
                    const int row = row0 + ai * 128 + m * 16;
#pragma unroll
                    for (int bj = 0; bj < 2; ++bj) { half8 o;
#pragma unroll
                        for (int q = 0; q < 4; ++q) { o[q] = (half_t)acc[ai][bj][m][0][q]; o[4 + q] = (half_t)acc[ai][bj][m][1][q]; }
                        *(half8*)(base + (size_t)row * CW + bj * 128) = o; }
                }
        }
    }
};
struct SchedOut {
    static constexpr bool GATHER = false;
    const unsigned char* ws; int G, c;
    __device__ __forceinline__ bool next(int i, Unit& u) const { const int L = i * G + c; if (L >= 256) return false; u.g = 0; static_order_unit(L, 64, 4, u.pm, u.pn); return true; }
    __device__ __forceinline__ const char* a_base(const Unit& u) const { return (const char*)(ws + WS_MIXA) + (size_t)u.pm * 256 * D * 2; }
    __device__ __forceinline__ const char* b_base(const Unit& u) const { return (const char*)(ws + WS_WOUT) + (size_t)u.pn * 256 * D * 2; }
};
struct EpiOut {
    static constexpr bool PERM = false;
    float* out;
    __device__ __forceinline__ void operator()(const f32x4 (&acc)[2][2][4][2], const Unit& u, int wr, int wc, int fr, int fq) const {
        const int row0 = u.pm * 256 + wr * 64 + fr, col0 = u.pn * 256 + wc * 32 + 4 * fq;
#pragma unroll
        for (int ai = 0; ai < 2; ++ai)
#pragma unroll
            for (int m = 0; m < 4; ++m) { float* rowp = out + (size_t)(row0 + ai * 128 + m * 16) * D + col0;
#pragma unroll
                for (int bj = 0; bj < 2; ++bj)
#pragma unroll
                    for (int n = 0; n < 2; ++n) *(f32x4*)(rowp + bj * 128 + n * 16) = acc[ai][bj][m][n]; }
    }
};
struct SchedGU {
    static constexpr bool GATHER = true;
    const unsigned char* ws; int G, c;
    __device__ __forceinline__ bool next(int i, Unit& u) const {
        const int L = i * G + c; if (L >= 2048) return false;
        if (G == 256) { const int x = c & 7, l = c >> 3, e = 2 * i + (x >> 2), pm8 = l & 7; u.g = (pm8 >> 2) * NE + e; u.pm = pm8 & 3; u.pn = (x & 3) * 4 + (l >> 3); }
        else { const int e = L >> 7, r = L & 127, pm8 = r & 7; u.g = (pm8 >> 2) * NE + e; u.pm = pm8 & 3; u.pn = r >> 3; }
        return true;
    }
    __device__ __forceinline__ const char* a_base(const Unit& u) const { return (const char*)(ws + WS_HX2); }
    __device__ __forceinline__ const char* b_base(const Unit& u) const { return (const char*)(ws + WS_WGU) + ((size_t)(u.g & 15) * 4096 + (size_t)u.pn * 256) * D * 2; }
    __device__ __forceinline__ void a_voff(const Unit& u, int tid, unsigned (&vo)[2][2]) const {
        const int* idx = (const int*)(ws + WS_IDX) + u.g * CAP + u.pm * 256; const int b = u.g >> 4;
#pragma unroll
        for (int i = 0; i < 2; ++i) { int R, C; pg8::stage_rc(tid * 16 + i * 8192, R, C);
#pragma unroll
            for (int h = 0; h < 2; ++h) vo[h][i] = (unsigned)((b * SEQ + idx[h * 128 + R]) * D + C) * 2u; }
    }
};
struct EpiGU {
    static constexpr bool PERM = true;
    unsigned char* ws;
    __device__ __forceinline__ void operator()(const f32x4 (&acc)[2][2][4][2], const Unit& u, int wr, int wc, int fr, int fq) const {
        half_t* base = (half_t*)(ws + WS_H) + ((size_t)u.g * CAP + u.pm * 256 + wr * 64 + fr) * DE + u.pn * 128 + wc * 32 + 8 * fq;
#pragma unroll
        for (int ai = 0; ai < 2; ++ai)
#pragma unroll
            for (int m = 0; m < 4; ++m) { half8 o;
#pragma unroll
                for (int q = 0; q < 4; ++q) { o[q] = (half_t)(fast_silu(acc[ai][0][m][0][q]) * acc[ai][1][m][0][q]); o[4 + q] = (half_t)(fast_silu(acc[ai][0][m][1][q]) * acc[ai][1][m][1][q]); }
                *(half8*)(base + (size_t)(ai * 128 + m * 16) * DE) = o; }
    }
};
struct SchedDown {
    static constexpr bool GATHER = false;
    const unsigned char* ws; int G, c;
    __device__ __forceinline__ bool next(int i, Unit& u) const {
        const int L = i * G + c; if (L >= 512) return false;
        if (G == 256) { const int x = c & 7, l = c >> 3, e = 8 * i + x, pm8 = l & 7; u.g = (pm8 >> 2) * NE + e; u.pm = pm8 & 3; u.pn = l >> 3; }
        else { const int e = L >> 5, r = L & 31, pm8 = r & 7; u.g = (pm8 >> 2) * NE + e; u.pm = pm8 & 3; u.pn = r >> 3; }
        return true;
    }
    __device__ __forceinline__ const char* a_base(const Unit& u) const { return (const char*)(ws + WS_H) + ((size_t)u.g * CAP + (size_t)u.pm * 256) * DE * 2; }
    __device__ __forceinline__ const char* b_base(const Unit& u) const { return (const char*)(ws + WS_WD) + ((size_t)(u.g & 15) * D + (size_t)u.pn * 256) * DE * 2; }
};
struct EpiDown {
    static constexpr bool PERM = true;
    unsigned char* ws;
    __device__ __forceinline__ void operator()(const f32x4 (&acc)[2][2][4][2], const Unit& u, int wr, int wc, int fr, int fq) const {
        const int slot0 = u.pm * 256 + wr * 64 + fr;
        const float* gate = (const float*)(ws + WS_GATE) + u.g * CAP;
        half_t* base = (half_t*)(ws + WS_Y) + ((size_t)u.g * CAP + slot0) * D + u.pn * 256 + wc * 32 + 8 * fq;
#pragma unroll
        for (int ai = 0; ai < 2; ++ai)
#pragma unroll
            for (int m = 0; m < 4; ++m) { const float gt = gate[slot0 + ai * 128 + m * 16];
#pragma unroll
                for (int bj = 0; bj < 2; ++bj) { half8 o;
#pragma unroll
                    for (int q = 0; q < 4; ++q) { o[q] = (half_t)(acc[ai][bj][m][0][q] * gt); o[4 + q] = (half_t)(acc[ai][bj][m][1][q] * gt); }
                    *(half8*)(base + (size_t)(ai * 128 + m * 16) * D + bj * 128) = o; } }
    }
};
__device__ __forceinline__ unsigned off_b(unsigned row, unsigned ch) { return 256u * row + 16u * (ch ^ (((row & 3u) << 2) | ((row >> 2) & 3u))); }
__device__ __forceinline__ half8 cat4(half4 a, half4 b) { return __builtin_shufflevector(a, b, 0, 1, 2, 3, 4, 5, 6, 7); }
#define TR8(o, a, b) asm volatile("ds_read_b64_tr_b16 %0, %8\n\tds_read_b64_tr_b16 %1, %8 offset:8192\n\tds_read_b64_tr_b16 %2, %8 offset:16384\n\tds_read_b64_tr_b16 %3, %8 offset:24576\n\t" \
    "ds_read_b64_tr_b16 %4, %9\n\tds_read_b64_tr_b16 %5, %9 offset:8192\n\tds_read_b64_tr_b16 %6, %9 offset:16384\n\tds_read_b64_tr_b16 %7, %9 offset:24576\n\t" \
    "s_waitcnt lgkmcnt(0)" : "=&v"(o[0]), "=&v"(o[1]), "=&v"(o[2]), "=&v"(o[3]), "=&v"(o[4]), "=&v"(o[5]), "=&v"(o[6]), "=&v"(o[7]) : "v"(a), "v"(b) : "memory")
struct TrLane { unsigned rowpart[2], X[2], pb, p8; };
__device__ __forceinline__ TrLane tr_lane(int lane) { TrLane t; const unsigned g = lane >> 4, q = (lane & 15) >> 2, p = lane & 3;
    for (unsigned tt = 0; tt < 2; ++tt) { t.rowpart[tt] = 256u * (8u * g + 4u * tt + q); t.X[tt] = (q << 2) | ((2u * g + tt) & 3u); } t.pb = p >> 1; t.p8 = 8u * (p & 1u); return t; }
__device__ __forceinline__ unsigned tr_addr(const TrLane& t, unsigned tile_base, unsigned c, int tt) { return tile_base + t.rowpart[tt] + 16u * ((2u * c + t.pb) ^ t.X[tt]) + t.p8; }
constexpr float LOG2E = 1.4426950408889634f;
__device__ __forceinline__ int chunk_row0(int b, int ch) { return ch < 2 ? M + b * CTXL + ch * 128 : b * SEQ + (ch - 2) * 128; }
__device__ void ph_r1(const P& p, int wg, int nwg, unsigned char* lds) {
    unsigned char* Kf = lds; unsigned char* Kb = lds + 32768; unsigned char* Vt = lds + 65536;
    const unsigned ldsbase = (unsigned)(size_t)lds;
    const half_t* Kg = (const half_t*)(p.ws + WS_K); const half_t* Vg = (const half_t*)(p.ws + WS_V); half_t* US = (half_t*)(p.ws + WS_US);
    const int wv = threadIdx.x >> 6;
    for (int it = wg; it < 8 * NCHK; it += nwg) {
        int lane = threadIdx.x & 63; asm volatile("" : "+v"(lane));
        const int tid = wv * 64 + lane, fr = lane & 15, fq = lane >> 4; const TrLane tl = tr_lane(lane);
        const int bh = it / NCHK, ch = it % NCHK, b = bh >> 2, h = bh & 3, row0 = chunk_row0(b, ch);
        const float lgf2 = log_sigmoid_f(p.decay[h]) * LOG2E, lgb2 = log_sigmoid_f(p.decay[4 + h]) * LOG2E;
        __syncthreads();
#pragma unroll
        for (int i = 0; i < 4; ++i) { const int n = tid + 512 * i, r = n >> 4, cn = n & 15;
            const half8 kv = *(const half8*)(Kg + (size_t)(row0 + r) * RW + h * 128 + cn * 8), vv = *(const half8*)(Vg + (size_t)(row0 + r) * RW + h * 128 + cn * 8);
            const float zf = __builtin_amdgcn_exp2f(lgf2 * (float)(127 - r)), zb = __builtin_amdgcn_exp2f(lgb2 * (float)r);
            half8 kf, kb;
#pragma unroll
            for (int q = 0; q < 8; ++q) { kf[q] = (half_t)((float)kv[q] * zf); kb[q] = (half_t)((float)kv[q] * zb); }
            const unsigned o = off_b(r, cn);
            *(half8*)(Kf + o) = kf; *(half8*)(Kb + o) = kb; *(half8*)(Vt + o) = vv; }
        __syncthreads();
        half4 o[8]; half8 Xf[4], Xb[4];
        TR8(o, tr_addr(tl, ldsbase, wv, 0), tr_addr(tl, ldsbase, wv, 1));
#pragma unroll
        for (int ks = 0; ks < 4; ++ks) Xf[ks] = cat4(o[ks], o[4 + ks]);
        TR8(o, tr_addr(tl, ldsbase + 32768u, wv, 0), tr_addr(tl, ldsbase + 32768u, wv, 1));
#pragma unroll
        for (int ks = 0; ks < 4; ++ks) Xb[ks] = cat4(o[ks], o[4 + ks]);
        half_t* dstf = US + ((size_t)(bh * NCHK + ch) * 2) * 16384 + (16 * wv + fr) * 128 + 4 * fq; half_t* dstb = dstf + 16384;
#pragma unroll
        for (int et = 0; et < 8; ++et) {
            TR8(o, tr_addr(tl, ldsbase + 65536u, et, 0), tr_addr(tl, ldsbase + 65536u, et, 1));
            f32x4 uf = (f32x4){0.f, 0.f, 0.f, 0.f}, ub = (f32x4){0.f, 0.f, 0.f, 0.f};
#pragma unroll
            for (int ks = 0; ks < 4; ++ks) { const half8 w = cat4(o[ks], o[4 + ks]); uf = __builtin_amdgcn_mfma_f32_16x16x32_f16(w, Xf[ks], uf, 0, 0, 0); ub = __builtin_amdgcn_mfma_f32_16x16x32_f16(w, Xb[ks], ub, 0, 0, 0); }
            half4 hf, hb;
#pragma unroll
            for (int r = 0; r < 4; ++r) { hf[r] = (half_t)uf[r]; hb[r] = (half_t)ub[r]; }
            *(half4*)(dstf + 16 * et) = hf; *(half4*)(dstb + 16 * et) = hb;
        }
    }
}
__device__ void ph_scan(const P& p, int wg, int nwg) {
    const half_t* US = (const half_t*)(p.ws + WS_US); half_t* SH = (half_t*)(p.ws + WS_SH);
    for (int i = wg * blockDim.x + threadIdx.x; i < 8 * 2 * 4096; i += nwg * blockDim.x) {
        const int el = (i & 4095) * 4, dir = (i >> 12) & 1, bh = i >> 13, h = bh & 3;
        const float g128 = expf(log_sigmoid_f(p.decay[dir * 4 + h]) * 128.0f);
        f32x4 S = (f32x4){0.f, 0.f, 0.f, 0.f};
        for (int s = 0; s < NCHK; ++s) {
            const int ch = dir == 0 ? s : (s == 0 ? 1 : (s == 1 ? 0 : 67 - s));
            const size_t o = ((size_t)(bh * NCHK + ch) * 2 + dir) * 16384 + el;
            const half4 uh = *(const half4*)(US + o); const f32x4 u = (f32x4){(float)uh[0], (float)uh[1], (float)uh[2], (float)uh[3]};
            half4 sh; sh[0] = (half_t)S[0]; sh[1] = (half_t)S[1]; sh[2] = (half_t)S[2]; sh[3] = (half_t)S[3];
            *(half4*)(SH + o) = sh; S = S * g128 + u;
        }
    }
}
__device__ void ph_r3(const P& p, int wg, int nwg, unsigned char* lds) {
    const int wv = threadIdx.x >> 6;
    unsigned char* Kt = lds; unsigned char* Vt = lds + 32768; unsigned char* St = lds + 65536; unsigned char* Pw = lds + 98304 + wv * 4096;
    const unsigned ldsbase = (unsigned)(size_t)lds;
    const half_t* Qg = (const half_t*)(p.ws + WS_Q); const half_t* Kg = (const half_t*)(p.ws + WS_K); const half_t* Vg = (const half_t*)(p.ws + WS_V); const half_t* Gg = (const half_t*)(p.ws + WS_G);
    const half_t* SH = (const half_t*)(p.ws + WS_SH); half_t* MIXA = (half_t*)(p.ws + WS_MIXA);
    for (int it = wg; it < 8 * 64; it += nwg) {
        int lane = threadIdx.x & 63; asm volatile("" : "+v"(lane));
        const int tid = wv * 64 + lane, fr = lane & 15, fq = lane >> 4; const TrLane tl = tr_lane(lane);
        const int bh = it >> 6, c = it & 63, b = bh >> 2, h = bh & 3, row0 = b * SEQ + c * 128, ch = c + 2, irow = 16 * wv + fr;
        const float lgf2 = log_sigmoid_f(p.decay[h]) * LOG2E, lgb2 = log_sigmoid_f(p.decay[4 + h]) * LOG2E;
        const half_t* Sfg = SH + ((size_t)(bh * NCHK + ch) * 2) * 16384; const half_t* Sbg = Sfg + 16384;
        __syncthreads();
        half8 qf[4];
#pragma unroll
        for (int ks = 0; ks < 4; ++ks) qf[ks] = *(const half8*)(Qg + (size_t)(row0 + irow) * RW + h * 128 + 32 * ks + 8 * fq);
#pragma unroll
        for (int i = 0; i < 4; ++i) { const int n = tid + 512 * i, r = n >> 4, cn = n & 15; const unsigned o = off_b(r, cn);
            *(half8*)(Kt + o) = *(const half8*)(Kg + (size_t)(row0 + r) * RW + h * 128 + cn * 8);
            *(half8*)(Vt + o) = *(const half8*)(Vg + (size_t)(row0 + r) * RW + h * 128 + cn * 8);
            *(half8*)(St + o) = *(const half8*)(Sfg + r * 128 + cn * 8); }
        __syncthreads();
        half8 sbv[4];
#pragma unroll
        for (int i = 0; i < 4; ++i) { const int n = tid + 512 * i; sbv[i] = *(const half8*)(Sbg + (n >> 4) * 128 + (n & 15) * 8); }
        const float xf = __builtin_amdgcn_exp2f(lgf2 * (float)(irow + 1)), xb = __builtin_amdgcn_exp2f(lgb2 * (float)(128 - irow));
#pragma unroll
        for (int jt = 0; jt < 8; ++jt) {
            f32x4 acc = (f32x4){0.f, 0.f, 0.f, 0.f};
#pragma unroll
            for (int ks = 0; ks < 4; ++ks) { const half8 kf = *(const half8*)(Kt + off_b(fr, 4 * ks + fq) + 4096 * jt); acc = __builtin_amdgcn_mfma_f32_16x16x32_f16(kf, qf[ks], acc, 0, 0, 0); }
            half4 ph;
#pragma unroll
            for (int r = 0; r < 4; ++r) { const int dd = irow - (16 * jt + 4 * fq + r); const float m = dd >= 0 ? __builtin_amdgcn_exp2f(lgf2 * (float)dd) : __builtin_amdgcn_exp2f(lgb2 * (float)(-dd)); ph[r] = (half_t)(acc[r] * m); }
            *(half4*)(Pw + off_b(fr, 2 * jt + (fq >> 1)) + 8 * (fq & 1)) = ph;
        }
        f32x4 Y[8]; half4 o[8];
#pragma unroll
        for (int et = 0; et < 8; ++et) {
            TR8(o, tr_addr(tl, ldsbase + 65536u, et, 0), tr_addr(tl, ldsbase + 65536u, et, 1));
            f32x4 acc = (f32x4){0.f, 0.f, 0.f, 0.f};
#pragma unroll
            for (int ks = 0; ks < 4; ++ks) acc = __builtin_amdgcn_mfma_f32_16x16x32_f16(cat4(o[ks], o[4 + ks]), qf[ks], acc, 0, 0, 0);
            Y[et] = acc * xf;
        }
        __syncthreads();
#pragma unroll
        for (int i = 0; i < 4; ++i) { const int n = tid + 512 * i; *(half8*)(Kt + off_b(n >> 4, n & 15)) = sbv[i]; }
        __syncthreads();
        half8 pf[4];
#pragma unroll
        for (int ks = 0; ks < 4; ++ks) pf[ks] = *(const half8*)(Pw + off_b(fr, 4 * ks + fq));
#pragma unroll
        for (int et = 0; et < 8; ++et) {
            TR8(o, tr_addr(tl, ldsbase + 32768u, et, 0), tr_addr(tl, ldsbase + 32768u, et, 1));
#pragma unroll
            for (int ks = 0; ks < 4; ++ks) Y[et] = __builtin_amdgcn_mfma_f32_16x16x32_f16(cat4(o[ks], o[4 + ks]), pf[ks], Y[et], 0, 0, 0);
            TR8(o, tr_addr(tl, ldsbase, et, 0), tr_addr(tl, ldsbase, et, 1));
            f32x4 acc = (f32x4){0.f, 0.f, 0.f, 0.f};
#pragma unroll
            for (int ks = 0; ks < 4; ++ks) acc = __builtin_amdgcn_mfma_f32_16x16x32_f16(cat4(o[ks], o[4 + ks]), qf[ks], acc, 0, 0, 0);
            Y[et] += acc * xb;
        }
        float s = 0.f;
#pragma unroll
        for (int et = 0; et < 8; ++et) s += (Y[et][0] + Y[et][1]) + (Y[et][2] + Y[et][3]);
        s += __shfl_xor(s, 16); s += __shfl_xor(s, 32);
        const float mu = s * (1.0f / 128.0f); float q2 = 0.f;
#pragma unroll
        for (int et = 0; et < 8; ++et) { const f32x4 d4 = Y[et] - mu; q2 += (d4[0] * d4[0] + d4[1] * d4[1]) + (d4[2] * d4[2] + d4[3] * d4[3]); }
        q2 += __shfl_xor(q2, 16); q2 += __shfl_xor(q2, 32);
        const float rstd = 1.0f / sqrtf(q2 * (1.0f / 128.0f) + GN_EPS);
        const half_t* grow = Gg + (size_t)(row0 + irow) * CW + h * 128 + 4 * fq; half_t* orow = MIXA + (size_t)(row0 + irow) * D + CW + h * 128 + 4 * fq; const float* ng = p.ret_norm_g + h * 128 + 4 * fq;
#pragma unroll
        for (int et = 0; et < 8; ++et) { const half4 g4 = *(const half4*)(grow + 16 * et); const f32x4 n4 = *(const f32x4*)(ng + 16 * et); half4 o4;
#pragma unroll
            for (int r = 0; r < 4; ++r) o4[r] = (half_t)(silu_f((float)g4[r]) * ((Y[et][r] - mu) * rstd * n4[r]));
            *(half4*)(orow + 16 * et) = o4; }
    }
}
__device__ void ph_conv(const P& p, int wg, int nwg) {
    const half_t* XB = (const half_t*)(p.ws + WS_XB); const half_t* XC = (const half_t*)(p.ws + WS_XC); const half_t* XX = (const half_t*)(p.ws + WS_XX); half_t* MIXA = (half_t*)(p.ws + WS_MIXA);
    for (int i = wg * blockDim.x + threadIdx.x; i < M * 64; i += nwg * blockDim.x) {
        const int row = i >> 6, ch0 = (i & 63) * 8, n = row & 63;
        const size_t o = (size_t)row * CW + ch0;
        const half8 c1 = *(const half8*)(XC + o), x1 = *(const half8*)(XX + o), bb = *(const half8*)(XB + o);
        half8 c0 = c1, x0 = x1, c2 = c1, x2 = x1;
        if (n != 0) { c0 = *(const half8*)(XC + o - CW); x0 = *(const half8*)(XX + o - CW); }
        if (n != 63) { c2 = *(const half8*)(XC + o + CW); x2 = *(const half8*)(XX + o + CW); }
        half8 r;
#pragma unroll
        for (int q = 0; q < 8; ++q) {
            const float up = n != 0 ? (float)c0[q] * (float)x0[q] : 0.f, u = (float)c1[q] * (float)x1[q], un = n != 63 ? (float)c2[q] * (float)x2[q] : 0.f;
            const float y = up * p.conv_w[ch0 + q] + u * p.conv_w[CW + ch0 + q] + un * p.conv_w[2 * CW + ch0 + q] + p.conv_b[ch0 + q];
            r[q] = (half_t)((float)bb[q] * y);
        }
        *(half8*)(MIXA + (size_t)row * D + ch0) = r;
    }
}
__device__ void ph_postmix(const P& p, int wg, int nwg) {
    const int lane = threadIdx.x & 63, wv = threadIdx.x >> 6, nwv = blockDim.x >> 6;
    const float* mod = (const float*)(p.ws + WS_MOD); half_t* HX2 = (half_t*)(p.ws + WS_HX2); float* AFF = (float*)(p.ws + WS_AFF);
    for (int row = wg * nwv + wv; row < M; row += nwg * nwv) {
        const int b = row / SEQ; const float* mb = mod + b * 6144;
        const float* g1 = mb + 2048; const float* sh2 = mb + 3072; const float* sc2 = mb + 4096;
        f32x4 mx[4], x1[4]; float ss = 0.f;
#pragma unroll
        for (int j = 0; j < 4; ++j) { mx[j] = ((const f32x4*)(p.out + (size_t)row * D))[lane + 64 * j]; ss += (mx[j][0] * mx[j][0] + mx[j][1] * mx[j][1]) + (mx[j][2] * mx[j][2] + mx[j][3] * mx[j][3]); }
        ss = wave_sum(ss); const float r1 = 1.0f / sqrtf(ss * (1.0f / D) + RMS_EPS);
        float s2 = 0.f;
#pragma unroll
        for (int j = 0; j < 4; ++j) { const int i0 = 4 * lane + 256 * j; const f32x4 xv = *(const f32x4*)(p.x + (size_t)row * D + i0), pg = *(const f32x4*)(p.post_mix_g + i0), gg = *(const f32x4*)(g1 + i0);
#pragma unroll
            for (int q = 0; q < 4; ++q) { x1[j][q] = xv[q] + gg[q] * (mx[j][q] * r1 * pg[q]); s2 += x1[j][q] * x1[j][q]; }
            *(f32x4*)(p.out + (size_t)row * D + i0) = x1[j]; }
        s2 = wave_sum(s2); const float r2 = 1.0f / sqrtf(s2 * (1.0f / D) + RMS_EPS);
        float lg[16];
#pragma unroll
        for (int e = 0; e < 16; ++e) lg[e] = 0.f;
#pragma unroll
        for (int j = 0; j < 4; ++j) { const int i0 = 4 * lane + 256 * j; const f32x4 pg = *(const f32x4*)(p.pre_ffn_g + i0), sc = *(const f32x4*)(sc2 + i0), sh = *(const f32x4*)(sh2 + i0);
            half4 o;
#pragma unroll
            for (int q = 0; q < 4; ++q) { const float hv = x1[j][q] * r2 * pg[q] * (1.0f + sc[q]) + sh[q]; o[q] = (half_t)hv;
                const f32x4* wr = (const f32x4*)(p.w_router + (size_t)(i0 + q) * NE);
#pragma unroll
                for (int e4 = 0; e4 < 4; ++e4) { const f32x4 w = wr[e4]; lg[e4 * 4 + 0] += hv * w[0]; lg[e4 * 4 + 1] += hv * w[1]; lg[e4 * 4 + 2] += hv * w[2]; lg[e4 * 4 + 3] += hv * w[3]; } }
            *(half4*)(HX2 + (size_t)row * D + i0) = o; }
        float mxl = -1e30f;
#pragma unroll
        for (int e = 0; e < 16; ++e) { lg[e] = wave_sum(lg[e]) + p.b_router[e]; mxl = fmaxf(mxl, lg[e]); }
        float den = 0.f;
#pragma unroll
        for (int e = 0; e < 16; ++e) { lg[e] = expf(lg[e] - mxl); den += lg[e]; }
        const float inv = 1.0f / den;
        float mine = 0.f;
#pragma unroll
        for (int e = 0; e < 16; ++e) if (lane == e) mine = lg[e] * inv;
        if (lane < 16) AFF[((size_t)b * NE + lane) * SEQ + (row & (SEQ - 1))] = mine;
    }
}
__device__ __forceinline__ int block_sum_i(int v, int* red) {
    __syncthreads();
    const int lane = threadIdx.x & 63, wv = threadIdx.x >> 6, nwv = blockDim.x >> 6;
#pragma unroll
    for (int o = 1; o < 64; o <<= 1) v += __shfl_xor(v, o);
    if (lane == 0) red[wv] = v;
    __syncthreads();
    int s = 0; for (int w = 0; w < nwv; ++w) s += red[w];
    return s;
}
__device__ __forceinline__ int block_exscan_i(int v, int* red) {
    __syncthreads();
    const int lane = threadIdx.x & 63, wv = threadIdx.x >> 6, nwv = blockDim.x >> 6;
    int inc = v;
#pragma unroll
    for (int o = 1; o < 64; o <<= 1) { const int t = __shfl_up(inc, o); if (lane >= o) inc += t; }
    if (lane == 63) red[wv] = inc;
    __syncthreads();
    int base = 0; for (int w = 0; w < nwv; ++w) if (w < wv) base += red[w];
    return base + inc - v;
}
__device__ void ph_topk(const P& p, int wg, int nwg, unsigned* lds) {
    unsigned* vals = lds; LAS int* hist = (LAS int*)(lds + SEQ); int* red = (int*)(lds + SEQ + 256); volatile int* sel = (volatile int*)(lds + SEQ + 256 + 16);
    const unsigned* AFFT = (const unsigned*)(p.ws + WS_AFF); int* IDX = (int*)(p.ws + WS_IDX); float* GATE = (float*)(p.ws + WS_GATE); int* INV = (int*)(p.ws + WS_INV);
    const int tid = threadIdx.x, nthr = blockDim.x, seg = SEQ / nthr, lane = tid & 63;
    for (int it = wg; it < NB * NE; it += nwg) {
        const int b = it / NE, e = it % NE;
        __syncthreads();
        for (int t = tid; t < SEQ; t += nthr) vals[t] = AFFT[(size_t)it * SEQ + t];
        unsigned prefix = 0u; int kth = CAP;
        for (int pass = 0; pass < 4; ++pass) {
            const int shift = 24 - 8 * pass; const unsigned himask = pass == 0 ? 0u : (0xFFFFFFFFu << (shift + 8));
            if (tid < 256) hist[tid] = 0;
            __syncthreads();
            for (int t = tid; t < SEQ; t += nthr) { const unsigned v = vals[t]; if ((v & himask) == prefix) __hip_atomic_fetch_add(hist + ((v >> shift) & 255u), 1, __ATOMIC_RELAXED, __HIP_MEMORY_SCOPE_WORKGROUP); }
            __syncthreads();
            if (tid < 64) {
                const int c0 = hist[255 - 4 * lane], c1 = hist[254 - 4 * lane], c2 = hist[253 - 4 * lane], c3 = hist[252 - 4 * lane], s = c0 + c1 + c2 + c3;
                int inc = s;
#pragma unroll
                for (int o = 1; o < 64; o <<= 1) { const int t = __shfl_up(inc, o); if (lane >= o) inc += t; }
                const unsigned long long m = __ballot(inc >= kth); const int first = m ? (__ffsll((long long)m) - 1) : 63;
                if (lane == first) { int cum = inc - s, d = 255 - 4 * lane;
                    if (cum + c0 < kth) { cum += c0; --d; if (cum + c1 < kth) { cum += c1; --d; if (cum + c2 < kth) { cum += c2; --d; } } }
                    sel[0] = (int)(prefix | ((unsigned)d << shift)); sel[1] = kth - cum; }
            }
            __syncthreads();
            prefix = (unsigned)sel[0]; kth = sel[1];
        }
        const unsigned T = prefix; const int need = kth;
        int ceq = 0;
        for (int t = tid * seg; t < tid * seg + seg; ++t) ceq += vals[t] == T ? 1 : 0;
        const int tie_base = block_exscan_i(ceq, red);
        int nsel = 0, tr = tie_base;
        for (int t = tid * seg; t < tid * seg + seg; ++t) { if (vals[t] > T) ++nsel; else if (vals[t] == T) { if (tr < need) ++nsel; ++tr; } }
        int slot = block_exscan_i(nsel, red); tr = tie_base;
        for (int t = tid * seg; t < tid * seg + seg; ++t) {
            bool s2 = false;
            if (vals[t] > T) s2 = true; else if (vals[t] == T) { s2 = tr < need; ++tr; }
            if (s2) { IDX[it * CAP + slot] = t; GATE[it * CAP + slot] = __uint_as_float(vals[t]); INV[(size_t)(b * SEQ + t) * NE + e] = slot; ++slot; }
            else INV[(size_t)(b * SEQ + t) * NE + e] = -1;
        }
    }
}
__device__ void ph_combine(const P& p, int wg, int nwg) {
    const int lane = threadIdx.x & 63, wv = threadIdx.x >> 6, nwv = blockDim.x >> 6;
    const float* mod = (const float*)(p.ws + WS_MOD); const int* INV = (const int*)(p.ws + WS_INV); const half_t* Y = (const half_t*)(p.ws + WS_Y);
    for (int row = wg * nwv + wv; row < M; row += nwg * nwv) {
        const int b = row / SEQ; const float* g2 = mod + b * 6144 + 5120;
        f32x4 acc[4];
#pragma unroll
        for (int j = 0; j < 4; ++j) acc[j] = (f32x4){0.f, 0.f, 0.f, 0.f};
        for (int e = 0; e < NE; ++e) { const int slot = INV[(size_t)row * NE + e];
            if (slot >= 0) { const half_t* yr = Y + ((size_t)(b * NE + e) * CAP + slot) * D;
#pragma unroll
                for (int j = 0; j < 4; ++j) { const half4 v = *(const half4*)(yr + 4 * lane + 256 * j); acc[j][0] += (float)v[0]; acc[j][1] += (float)v[1]; acc[j][2] += (float)v[2]; acc[j][3] += (float)v[3]; } } }
        float ss = 0.f;
#pragma unroll
        for (int j = 0; j < 4; ++j) ss += (acc[j][0] * acc[j][0] + acc[j][1] * acc[j][1]) + (acc[j][2] * acc[j][2] + acc[j][3] * acc[j][3]);
        ss = wave_sum(ss); const float r = 1.0f / sqrtf(ss * (1.0f / D) + RMS_EPS);
#pragma unroll
        for (int j = 0; j < 4; ++j) { const int i0 = 4 * lane + 256 * j; const f32x4 x1 = *(const f32x4*)(p.out + (size_t)row * D + i0), pg = *(const f32x4*)(p.post_ffn_g + i0), gg = *(const f32x4*)(g2 + i0);
            f32x4 o;
#pragma unroll
            for (int q = 0; q < 4; ++q) o[q] = x1[q] + gg[q] * (acc[j][q] * r * pg[q]);
            *(f32x4*)(p.out + (size_t)row * D + i0) = o; }
    }
}
#define XB_TMO      128
#define XB_XCNT(j)  (256  + 64 * (j))
#define XB_XSUB(j)  (1280 + 64 * (j))
#define XB_XGEN(j)  (2304 + 64 * (j))
#define XB_TOP      3328
#define XB_TOPGEN   3392
#define XCD_BAR_WORDS 3456
#define XB_SPIN_CAP (1u << 18)
__device__ __forceinline__ unsigned xb_ld(unsigned* p)              { return __hip_atomic_load(p, __ATOMIC_RELAXED, __HIP_MEMORY_SCOPE_AGENT); }
__device__ __forceinline__ unsigned xb_add(unsigned* p, unsigned v) { return __hip_atomic_fetch_add(p, v, __ATOMIC_RELAXED, __HIP_MEMORY_SCOPE_AGENT); }
__device__ __forceinline__ unsigned xb_xcc_id() { return (unsigned)__builtin_amdgcn_s_getreg((3 << 11) | 20) & 0xFu; }
#define XB_SPIN(cond, bar) do { unsigned _sp = 0; while (cond) { __builtin_amdgcn_s_sleep(1); \
    if ((++_sp & 255u) == 0u) { if (xb_ld(&(bar)[XB_TMO])) break; if (_sp > XB_SPIN_CAP) { atomicAdd(&(bar)[XB_TMO], 1u); break; } } } } while (0)
struct XcdBarrier { unsigned* bar; unsigned x; volatile LAS unsigned* st; };
__device__ __forceinline__ XcdBarrier xcd_barrier_post(unsigned* bar, volatile LAS unsigned* st) {
    XcdBarrier b; b.bar = bar; b.x = xb_xcc_id(); b.st = st;
    if (threadIdx.x == 0) (void)xb_add(&bar[XB_XCNT(b.x)], 1u);
    return b;
}
__device__ __forceinline__ void xcd_barrier_complete(unsigned* bar, unsigned x, unsigned& nloc, unsigned& nx) {
    const unsigned G = gridDim.x * gridDim.y * gridDim.z;
    unsigned sum, cnt, mine, sp = 0u;
    for (;;) {
        sum = 0u; cnt = 0u; mine = 0u;
#pragma unroll
        for (unsigned j = 0; j < 16; ++j) { const unsigned c = xb_ld(&bar[XB_XCNT(j)]); sum += c; cnt += (c > 0u) ? 1u : 0u; mine = (j == x) ? c : mine; }
        if (sum == G) break;
        __builtin_amdgcn_s_sleep(1);
        if ((++sp & 255u) == 0u) { if (xb_ld(&bar[XB_TMO])) break; if (sp > XB_SPIN_CAP) { atomicAdd(&bar[XB_TMO], 1u); break; } }
    }
    nloc = mine > 0u ? mine : 1u; nx = cnt > 0u ? cnt : 1u;
}
__device__ __forceinline__ void xcd_barrier(const XcdBarrier& b) {
    asm volatile("s_waitcnt vmcnt(0)" ::: "memory");
    __syncthreads();
    if (threadIdx.x == 0) {
        unsigned* bar = b.bar;
        __builtin_amdgcn_s_waitcnt(0);
        unsigned nloc = b.st[0], nx = b.st[1];
        if (nloc == 0u) { xcd_barrier_complete(bar, b.x, nloc, nx); b.st[0] = nloc; b.st[1] = nx; }
        const unsigned old = xb_add(&bar[XB_XSUB(b.x)], 1u);
        const unsigned gen = old / nloc;
        if (old + 1u == (gen + 1u) * nloc) {
            __builtin_amdgcn_fence(__ATOMIC_RELEASE, "agent");
            asm volatile("s_waitcnt vmcnt(0)" ::: "memory");
            const unsigned og = xb_add(&bar[XB_TOP], 1u);
            const unsigned tg = og / nx;
            if (og + 1u == (tg + 1u) * nx) xb_add(&bar[XB_TOPGEN], 1u);
            else XB_SPIN(xb_ld(&bar[XB_TOPGEN]) == tg, bar);
            __builtin_amdgcn_fence(__ATOMIC_ACQUIRE, "agent");
            xb_add(&bar[XB_XGEN(b.x)], 1u);
            asm volatile("s_waitcnt vmcnt(0)" ::: "memory");
        } else {
            XB_SPIN(xb_ld(&bar[XB_XGEN(b.x)]) == gen, bar);
            __builtin_amdgcn_fence(__ATOMIC_ACQUIRE, "agent");
            asm volatile("s_waitcnt vmcnt(0)" ::: "memory");
        }
    }
    __syncthreads();
}
constexpr int LDS_BYTES = 147456;
constexpr int MISC_OFF = LDS_BYTES - 128;
constexpr size_t CTL_ZERO_BYTES = 65536;
#define REP_P0 0
#define REP_HX 0
#define REP_GEMM 0
#define REP_RET 0
#define REP_TOPK 0
#define REPEAT(n) for (int rep_ = 0; rep_ < 1 + (n); ++rep_)
__global__ void __launch_bounds__(512, 2) mega_fwd(P p) {
    extern __shared__ __attribute__((aligned(16))) unsigned char lds[];
    const int wg = blockIdx.x, nwg = gridDim.x;
    volatile LAS unsigned* MISC = (volatile LAS unsigned*)((LAS unsigned char*)lds + MISC_OFF);
    if (threadIdx.x < 32) MISC[threadIdx.x] = 0u;
    __syncthreads();
    const XcdBarrier bar = xcd_barrier_post((unsigned*)(p.ws + WS_CTL) + 4096, MISC + 8);
    REPEAT(REP_P0) { ph_mod_partial(p, wg, nwg); ph_rope(p, wg, nwg); ph_prep_weights(p, wg, nwg, (float*)lds); }
    xcd_barrier(bar);
    REPEAT(REP_HX) ph_hx(p, wg, nwg, (float*)lds);
    xcd_barrier(bar);
    REPEAT(REP_GEMM) { const SchedIn S{p.ws, nwg, wg}; const EpiIn E{p.ws}; pg8::gemm_phase<EpiIn, SchedIn, true>((PG8_LAS unsigned char*)lds, D, S, E); }
    xcd_barrier(bar);
    REPEAT(REP_RET) { ph_r1(p, wg, nwg, lds); ph_conv(p, wg, nwg); }
    xcd_barrier(bar);
    REPEAT(REP_RET) ph_scan(p, wg, nwg);
    xcd_barrier(bar);
    REPEAT(REP_RET) ph_r3(p, wg, nwg, lds);
    xcd_barrier(bar);
    REPEAT(REP_GEMM) { const SchedOut S{p.ws, nwg, wg}; const EpiOut E{p.out}; pg8::gemm_phase<EpiOut, SchedOut, false>((PG8_LAS unsigned char*)lds, D, S, E); }
    xcd_barrier(bar);
    ph_postmix(p, wg, nwg);
    xcd_barrier(bar);
    REPEAT(REP_TOPK) ph_topk(p, wg, nwg, (unsigned*)lds);
    xcd_barrier(bar);
    REPEAT(REP_GEMM) { const SchedGU S{p.ws, nwg, wg}; const EpiGU E{p.ws}; pg8::gemm_phase<EpiGU, SchedGU, true>((PG8_LAS unsigned char*)lds, D, S, E); }
    xcd_barrier(bar);
    REPEAT(REP_GEMM) { const SchedDown S{p.ws, nwg, wg}; const EpiDown E{p.ws}; pg8::gemm_phase<EpiDown, SchedDown, true>((PG8_LAS unsigned char*)lds, DE, S, E); }
    xcd_barrier(bar);
    ph_combine(p, wg, nwg);
}

extern "C" void kernel_launch(void* const* d_in, const int* in_sizes, int n_in, void* d_out, int out_size, void* d_ws, size_t ws_size, hipStream_t stream) {
    static int grid = 0;
    if (grid == 0) {
        if (n_in != 21 || ws_size < WS_END || out_size != M * D) { fprintf(stderr, "kernel_launch: unexpected shapes n_in %d ws %zu out %d\n", n_in, ws_size, out_size); grid = -1; return; }
        int dev = 0, cus = 0, per_cu = 0;
        if (hipGetDevice(&dev) != hipSuccess || hipDeviceGetAttribute(&cus, hipDeviceAttributeMultiprocessorCount, dev) != hipSuccess) { grid = -1; return; }
        if (hipFuncSetAttribute((const void*)mega_fwd, hipFuncAttributeMaxDynamicSharedMemorySize, LDS_BYTES) != hipSuccess) { fprintf(stderr, "kernel_launch: hipFuncSetAttribute failed\n"); grid = -1; return; }
        if (hipOccupancyMaxActiveBlocksPerMultiprocessor(&per_cu, (const void*)mega_fwd, 512, LDS_BYTES) != hipSuccess || per_cu < 1) { fprintf(stderr, "kernel_launch: occupancy query says %d\n", per_cu); (void)hipGetLastError(); per_cu = 1; }
        grid = cus;
    }
    if (grid < 0) return;
    if (hipMemsetAsync((char*)d_ws + WS_CTL, 0, CTL_ZERO_BYTES, stream) != hipSuccess) return;
    P p{};
    const float** f = (const float**)&p;
    for (int i = 0; i < 21; ++i) f[i] = (const float*)d_in[i];
    p.out = (float*)d_out; p.ws = (unsigned char*)d_ws;
    hipLaunchKernelGGL(mega_fwd, dim3(grid), dim3(512), LDS_BYTES, stream, p);
}
```

```cpp
#include <hip/hip_runtime.h>
#include <cstdint>
#include <cstdio>

typedef _Float16 half_t;
typedef _Float16 half8 __attribute__((ext_vector_type(8)));
typedef _Float16 half4 __attribute__((ext_vector_type(4)));
typedef float f32x4 __attribute__((ext_vector_type(4)));
#define LAS __attribute__((address_space(3)))
#define PROBE_K 0
#define PROBE_SCALE 1e-4f

constexpr int D = 1024, NB = 2, SEQ = 8192, M = NB * SEQ, CTXL = 256, MC = NB * CTXL, MR = M + MC;
constexpr int CW = 512, NH = 4, HD = 128, RW = 512, INC = 3584;
constexpr int NCHK = 66;
constexpr int NE = 16, CAP = 1024, DE = 2048;
constexpr float RMS_EPS = 1e-6f, GN_EPS = 1e-6f;

constexpr size_t MiB = 1u << 20;
constexpr size_t WS_CTL = 0;
constexpr size_t WS_MODP = 1 * MiB;
constexpr size_t WS_MOD = 3 * MiB;
constexpr size_t WS_ROPE = 4 * MiB;
constexpr size_t WS_ROPE_SIN = WS_ROPE + 2560 * 1024;
constexpr size_t WS_AFF = 9 * MiB;
constexpr size_t WS_IDX = 10 * MiB;
constexpr size_t WS_GATE = WS_IDX + 256 * 1024;
constexpr size_t WS_INV = 11 * MiB;
constexpr size_t WS_WIN = 12 * MiB;
constexpr size_t WS_WOUT = 19 * MiB;
constexpr size_t WS_WGU = 21 * MiB;
constexpr size_t WS_WD = 149 * MiB;
constexpr size_t WS_A = 213 * MiB;
constexpr size_t WS_HX = WS_A, WS_MIXA = WS_A + 33 * MiB, WS_HX2 = WS_A, WS_Y = WS_A;
constexpr size_t WS_SH = WS_A;
constexpr size_t WS_B = 279 * MiB;
constexpr size_t WS_XB = WS_B, WS_XC = WS_B + 16 * MiB, WS_XX = WS_B + 32 * MiB, WS_G = WS_B + 48 * MiB;
constexpr size_t WS_Q = WS_B + 64 * MiB, WS_K = WS_Q + 17 * MiB, WS_V = WS_K + 17 * MiB;
constexpr size_t WS_US = WS_V + 17 * MiB;
constexpr size_t WS_H = WS_B;
constexpr size_t WS_END = WS_US + 66 * MiB;
static_assert(WS_H + 128 * MiB <= WS_END, "H overlay");

struct P {
    const float *x, *c, *ctx, *c_ctx, *w_ada, *b_ada, *pre_mix_g, *post_mix_g, *pre_ffn_g, *post_ffn_g, *w_in, *conv_w, *conv_b, *decay, *ret_norm_g, *w_out,
        *w_router, *b_router, *w_gate, *w_up, *w_down;
    float* out; unsigned char* ws;
};

__device__ __forceinline__ float wave_sum(float v) {
#pragma unroll
    for (int o = 1; o < 64; o <<= 1) v += __shfl_xor(v, o);
    return v;
}
__device__ __forceinline__ float silu_f(float v) { return v / (1.0f + expf(-v)); }
__device__ __forceinline__ float log_sigmoid_f(float v) { return v >= 0.f ? -log1pf(expf(-v)) : v - log1pf(expf(v)); }

__host__ __device__ __forceinline__ int in_col_src(int R) {
    if (R < 1536 || R >= 2560) return R;
    const int sec_base = R < 2048 ? 1536 : 2048, r = R - sec_base, t = r >> 8, c = r & 255, hi = c >> 7, cc = c & 127;
    return sec_base + (2 * t + (cc >> 6)) * 128 + hi * 64 + (cc & 63);
}

__device__ void ph_mod_partial(const P& p, int wg, int nwg) {
    const int sub = threadIdx.x >> 8, nsub = blockDim.x >> 8, t = threadIdx.x & 255;
    float* part = (float*)(p.ws + WS_MODP);
    for (int it = wg * nsub + sub; it < 24 * 16; it += nwg * nsub) {
        const int cb = it % 24, ks = it / 24, col = cb * 256 + t;
        float a0 = 0.f, a1 = 0.f, a2 = 0.f;
        for (int k = ks * 64; k < ks * 64 + 64; ++k) {
            const float w = p.w_ada[(size_t)k * 6144 + col];
            a0 += silu_f(p.c[k]) * w; a1 += silu_f(p.c[1024 + k]) * w; a2 += silu_f(p.c_ctx[k]) * w;
        }
        part[(ks * 3 + 0) * 6144 + col] = a0; part[(ks * 3 + 1) * 6144 + col] = a1; part[(ks * 3 + 2) * 6144 + col] = a2;
    }
}
__device__ void ph_rope(const P& p, int wg, int nwg) {
    float* ct = (float*)(p.ws + WS_ROPE); float* st = (float*)(p.ws + WS_ROPE_SIN);
    for (int i = wg * blockDim.x + threadIdx.x; i < 8448 * 64; i += nwg * blockDim.x) {
        const int pos = i >> 6, j = i & 63;
        const float inv = 1.0f / powf(10000.0f, (float)j / 64.0f);
        const float ang = (float)pos * inv;
        const double a = (double)ang; const double kk = rint(a * 0.15915494309189535); const double r = a - kk * 6.283185307179586476925;
        ct[i] = (float)cos(r); st[i] = (float)sin(r);
    }
}
template <class Map>
__device__ __forceinline__ void transpose_item(const float* W, int K, int N, half_t* WT, float* scr, int item, int lane, Map srcmap) {
    const int nblk = N / 32, kb = item / nblk, nb = item % nblk, k0 = 64 * kb, n0 = 32 * nb;
    const int scol = srcmap(n0 + (lane & 31));
#pragma unroll 8
    for (int i = 0; i < 32; ++i) { const int kk = 2 * i + (lane >> 5); scr[kk * 33 + (lane & 31)] = W[(size_t)(k0 + kk) * N + scol]; }
    __builtin_amdgcn_s_waitcnt(0xc07f); asm volatile("" ::: "memory");
    const int c = lane & 7;
#pragma unroll
    for (int j = 0; j < 4; ++j) { const int n = (lane >> 3) + 8 * j; const float* s = scr + (8 * c) * 33 + n;
        half8 o;
#pragma unroll
        for (int q = 0; q < 8; ++q) o[q] = (half_t)s[q * 33];
        *(half8*)(WT + (size_t)(n0 + n) * K + k0 + 8 * c) = o; }
    __builtin_amdgcn_s_waitcnt(0xc07f); asm volatile("" ::: "memory");
}
struct MapId { __device__ int operator()(int R) const { return R; } };
struct MapIn { __device__ int operator()(int R) const { return in_col_src(R); } };
__device__ void ph_prep_weights(const P& p, int wg, int nwg, float* lds_f) {
    const int lane = threadIdx.x & 63, wv = threadIdx.x >> 6, nwv = blockDim.x >> 6;
    float* scr = lds_f + wv * (64 * 33);
    half_t* Win = (half_t*)(p.ws + WS_WIN); half_t* Wout = (half_t*)(p.ws + WS_WOUT); half_t* Wgu = (half_t*)(p.ws + WS_WGU); half_t* Wd = (half_t*)(p.ws + WS_WD);
    constexpr int I_IN = (D / 64) * (INC / 32), I_OUT = (D / 64) * (D / 32), I_G = (D / 64) * (DE / 32), I_D = (DE / 64) * (D / 32);
    constexpr int NIT = I_IN + I_OUT + NE * (2 * I_G + I_D);
    for (int it = wg * nwv + wv; it < NIT; it += nwg * nwv) {
        int r = it;
        if (r < I_IN) { transpose_item(p.w_in, D, INC, Win, scr, r, lane, MapIn()); continue; } r -= I_IN;
        if (r < I_OUT) { transpose_item(p.w_out, D, D, Wout, scr, r, lane, MapId()); continue; } r -= I_OUT;
        const int e = r / (2 * I_G + I_D); r -= e * (2 * I_G + I_D);
        if (r < 2 * I_G) {
            const int which = r / I_G, item = r % I_G;
            const float* W = (which ? p.w_up : p.w_gate) + (size_t)e * D * DE;
            const int nblk = DE / 32, kb = item / nblk, nb = item % nblk, k0 = 64 * kb, n0 = 32 * nb;
            half_t* WT = Wgu + (size_t)e * 4096 * D;
#pragma unroll 8
            for (int i = 0; i < 32; ++i) { const int kk = 2 * i + (lane >> 5); scr[kk * 33 + (lane & 31)] = W[(size_t)(k0 + kk) * DE + n0 + (lane & 31)]; }
            __builtin_amdgcn_s_waitcnt(0xc07f); asm volatile("" ::: "memory");
            const int c = lane & 7;
#pragma unroll
            for (int j = 0; j < 4; ++j) { const int n = (lane >> 3) + 8 * j; const float* s = scr + (8 * c) * 33 + n;
                half8 o;
#pragma unroll
                for (int q = 0; q < 8; ++q) o[q] = (half_t)s[q * 33];
                *(half8*)(WT + (size_t)((n0 >> 7) * 256 + which * 128 + (n0 & 127) + n) * D + k0 + 8 * c) = o; }
            __builtin_amdgcn_s_waitcnt(0xc07f); asm volatile("" ::: "memory");
            continue;
        }
        r -= 2 * I_G;
        transpose_item(p.w_down + (size_t)e * DE * D, DE, D, Wd + (size_t)e * D * DE, scr, r, lane, MapId());
    }
}
__device__ void ph_hx(const P& p, int wg, int nwg, float* lds) {
    const int tid = threadIdx.x, nthr = blockDim.x, lane = tid & 63, wv = tid >> 6;
    const float* part = (const float*)(p.ws + WS_MODP); float* mod = (float*)(p.ws + WS_MOD); half_t* HX = (half_t*)(p.ws + WS_HX);
    for (int i = wg * nthr + tid; i < 3 * 6144; i += nwg * nthr) {
        float s = p.b_ada[i % 6144];
        for (int ks = 0; ks < 16; ++ks) s += part[ks * 3 * 6144 + i];
        mod[i] = s;
    }
    float* sv = lds;
    for (int blk = wg; blk < 264; blk += nwg) {
        const int mr = blk < 256 ? (blk >> 7) : 2, base = blk < 256 ? blk * 64 : M + (blk - 256) * 64;
        __syncthreads();
        for (int i = tid; i < 2048; i += nthr) { float s = p.b_ada[i];
            for (int ks = 0; ks < 16; ++ks) s += part[(ks * 3 + mr) * 6144 + i];
            sv[i] = s; }
        __syncthreads();
        for (int rr = 0; rr < 8; rr += 2) {
            const int row = base + wv * 8 + rr;
            const float* s0 = row < M ? p.x + (size_t)row * D : p.ctx + (size_t)(row - M) * D; const float* s1 = s0 + D;
            f32x4 v0[4], v1[4]; float a0 = 0.f, a1 = 0.f;
#pragma unroll
            for (int j = 0; j < 4; ++j) { v0[j] = ((const f32x4*)s0)[lane + 64 * j]; v1[j] = ((const f32x4*)s1)[lane + 64 * j]; }
#pragma unroll
            for (int j = 0; j < 4; ++j) { a0 += (v0[j][0] * v0[j][0] + v0[j][1] * v0[j][1]) + (v0[j][2] * v0[j][2] + v0[j][3] * v0[j][3]); a1 += (v1[j][0] * v1[j][0] + v1[j][1] * v1[j][1]) + (v1[j][2] * v1[j][2] + v1[j][3] * v1[j][3]); }
            a0 = wave_sum(a0); a1 = wave_sum(a1);
            const float r0 = 1.0f / sqrtf(a0 * (1.0f / D) + RMS_EPS), r1 = 1.0f / sqrtf(a1 * (1.0f / D) + RMS_EPS);
#pragma unroll
            for (int j = 0; j < 4; ++j) { const int i0 = 4 * lane + 256 * j;
                const f32x4 g = *(const f32x4*)(p.pre_mix_g + i0), h = *(const f32x4*)(sv + i0), s = *(const f32x4*)(sv + 1024 + i0);
                half4 o0, o1;
#pragma unroll
                for (int q = 0; q < 4; ++q) { const float gs = g[q] * (1.0f + s[q]); o0[q] = (half_t)(v0[j][q] * r0 * gs + h[q]); o1[q] = (half_t)(v1[j][q] * r1 * gs + h[q]); }
                *(half4*)(HX + (size_t)row * D + i0) = o0; *(half4*)(HX + (size_t)(row + 1) * D + i0) = o1; }
        }
    }
}
namespace pg8 {
#define PG8_LAS __attribute__((address_space(3)))
constexpr int BM = 256, BK = 64, HALF = 128, HTB = HALF * BK * 2  , STAGE_BYTES = 8 * HTB, NXCD = 8, WGM = 8;
__host__ __device__ __forceinline__ int lds_byte(int r, int c) { const int st = (r >> 4) * 2 + (c >> 5), rr = r & 15, cc = c & 31, ob = rr * 64 + cc * 2; return st * 1024 + (ob ^ (((ob >> 9) & 1) << 5)); }
__host__ __device__ __forceinline__ void stage_rc(int b, int& R, int& C) { const int st = b / 1024, sb = b % 1024, swz = sb ^ (((sb >> 9) & 1) << 5); R = (st >> 1) * 16 + swz / 64; C = (st & 1) * 32 + (swz % 64) / 2; }
__host__ __device__ __forceinline__ int perm32(int rho) { const int n = rho >> 4, i = rho & 15; return 8 * (i >> 2) + 4 * n + (i & 3); }
struct Unit { int pm, pn, g; };
template <class Epi, class Sched, bool ALIGN_EPI>
__device__ __forceinline__ void gemm_phase(PG8_LAS unsigned char* lds, const int K, const Sched& S, const Epi& E) {
    int tid = threadIdx.x; asm volatile("" : "+v"(tid));
    const int wid = __builtin_amdgcn_readfirstlane(tid >> 6), lane = tid & 63, wr = wid >> 2, wc = wid & 3, fr = lane & 15, fq = lane >> 4;
    const int nt = K / BK;
    constexpr bool GA = Sched::GATHER;
    unsigned voffB[2], voffA[2];
#pragma unroll
    for (int i = 0; i < 2; ++i) { int R, C; stage_rc(tid * 16 + i * 8192, R, C); const int Rb = Epi::PERM ? ((R & ~31) + perm32(R & 31)) : R; voffB[i] = (unsigned)(Rb * K + C) * 2u; voffA[i] = (unsigned)(R * K + C) * 2u; }
    const size_t kstep = (size_t)(BK * 2);
    const size_t hstep = (size_t)HALF * K * 2;
    const unsigned ldsw = (unsigned)wid * 1024u;
    const int aoff = lds_byte(wr * 64 + fr, fq * 8), boff = lds_byte(wc * 32 + fr, fq * 8);
#define PG8_SA(b, h) (((b) * 2 + (h)) * HTB)
#define PG8_SB(b, h) ((4 + (b) * 2 + (h)) * HTB)
#define PG8_STAGE(bufoff, gbase, voff) do { _Pragma("unroll") for (int _i = 0; _i < 2; ++_i) \
        __builtin_amdgcn_global_load_lds((const unsigned*)((const char*)(gbase) + (voff)[_i]), (PG8_LAS unsigned*)(lds + (bufoff) + ldsw + _i * 8192), 16, 0, 0); } while (0)
#define PG8_LDA(dst, b, h) do { _Pragma("unroll") for (int m = 0; m < 4; ++m) _Pragma("unroll") for (int k = 0; k < 2; ++k) dst[m][k] = *(const PG8_LAS half8*)(lds + PG8_SA(b, h) + aoff + m * 2048 + k * 1024); } while (0)
#define PG8_LDB(dst, b, h) do { _Pragma("unroll") for (int n = 0; n < 2; ++n) _Pragma("unroll") for (int k = 0; k < 2; ++k) dst[n][k] = *(const PG8_LAS half8*)(lds + PG8_SB(b, h) + boff + n * 2048 + k * 1024); } while (0)
#define PG8_MMA(ai, bj, At, Bt) do { __builtin_amdgcn_s_setprio(1); _Pragma("unroll") for (int m = 0; m < 4; ++m) _Pragma("unroll") for (int n = 0; n < 2; ++n) _Pragma("unroll") for (int k = 0; k < 2; ++k) \
        acc[ai][bj][m][n] = __builtin_amdgcn_mfma_f32_16x16x32_f16(Bt[n][k], At[m][k], acc[ai][bj][m][n], 0, 0, 0); __builtin_amdgcn_s_setprio(0); } while (0)
#define PG8_WAIT_V(n) asm volatile("s_waitcnt vmcnt(" #n ")" ::: "memory")
#define PG8_WAIT_L(n) asm volatile("s_waitcnt lgkmcnt(" #n ")" ::: "memory")
#define PG8_BAR __builtin_amdgcn_s_barrier()
#define PG8_SCHED __builtin_amdgcn_sched_barrier(0)
    Unit cur, nxt; int ui = 0;
    if (!S.next(0, cur)) return;
    f32x4 acc[2][2][4][2];
#pragma unroll
    for (int a = 0; a < 2; ++a)
#pragma unroll
        for (int b = 0; b < 2; ++b)
#pragma unroll
            for (int m = 0; m < 4; ++m)
#pragma unroll
                for (int n = 0; n < 2; ++n) acc[a][b][m][n] = (f32x4){0.f, 0.f, 0.f, 0.f};
    half8 At[4][2], B0[2][2], B1[2][2];
    unsigned vo[2][2], nvo[2][2];
    const size_t hstepA = GA ? (size_t)0 : hstep;
#pragma unroll
    for (int i = 0; i < 2; ++i) { vo[0][i] = voffA[i]; vo[1][i] = voffA[i]; }
    if constexpr (GA) S.a_voff(cur, tid, vo);
    const char* cA = S.a_base(cur); const char* cB = S.b_base(cur);
    PG8_STAGE(PG8_SB(0, 0), cB, voffB); PG8_STAGE(PG8_SB(0, 1), cB + hstep, voffB); PG8_STAGE(PG8_SA(0, 0), cA, vo[0]); PG8_STAGE(PG8_SA(0, 1), cA + hstepA, vo[1]);
    if (wr == 1) PG8_BAR;
    PG8_WAIT_V(2); PG8_BAR;
    PG8_STAGE(PG8_SB(1, 0), cB + kstep, voffB); PG8_STAGE(PG8_SA(1, 0), cA + kstep, vo[0]); PG8_STAGE(PG8_SB(1, 1), cB + hstep + kstep, voffB);
    PG8_WAIT_V(6); PG8_BAR;
    for (;;) {
        const bool has_next = S.next(ui + 1, nxt);
        const char* nA = cA; const char* nB = cB;
        if constexpr (GA) {
#pragma unroll
            for (int h = 0; h < 2; ++h)
#pragma unroll
                for (int i = 0; i < 2; ++i) nvo[h][i] = vo[h][i];
        }
        if (has_next) { nA = S.a_base(nxt); nB = S.b_base(nxt); if constexpr (GA) S.a_voff(nxt, tid, nvo); }
        for (int t = 0; t < nt; t += 2) {
            const bool last = (t == nt - 2);
            const char* a1 = cA + (size_t)(t + 1) * kstep;
            const char* a2 = last ? nA : cA + (size_t)(t + 2) * kstep; const char* b2 = last ? nB : cB + (size_t)(t + 2) * kstep;
            const char* a3 = a2 + kstep; const char* b3 = b2 + kstep;
            unsigned v2[2][2];
#pragma unroll
            for (int h = 0; h < 2; ++h)
#pragma unroll
                for (int i = 0; i < 2; ++i) v2[h][i] = GA ? (last ? nvo[h][i] : vo[h][i]) : voffA[i];
            PG8_LDB(B0, 0, 0); PG8_LDB(B1, 0, 1); PG8_SCHED; PG8_LDA(At, 0, 0); PG8_STAGE(PG8_SA(1, 1), a1 + hstepA, vo[1]);
            PG8_WAIT_V(8); PG8_WAIT_L(0); PG8_BAR; PG8_MMA(0, 0, At, B0); PG8_MMA(0, 1, At, B1); PG8_BAR; PG8_SCHED;
            PG8_LDA(At, 0, 1); PG8_STAGE(PG8_SB(0, 0), b2, voffB); PG8_STAGE(PG8_SB(0, 1), b2 + hstep, voffB); PG8_STAGE(PG8_SA(0, 0), a2, v2[0]);
            PG8_WAIT_V(8); PG8_WAIT_L(0); PG8_BAR; PG8_MMA(1, 0, At, B0); PG8_MMA(1, 1, At, B1); PG8_BAR; PG8_SCHED;
            PG8_LDB(B0, 1, 0); PG8_LDB(B1, 1, 1); PG8_SCHED; PG8_LDA(At, 1, 0); PG8_STAGE(PG8_SA(0, 1), a2 + hstepA, v2[1]);
            PG8_WAIT_V(8); PG8_WAIT_L(0); PG8_BAR; PG8_MMA(0, 0, At, B0); PG8_MMA(0, 1, At, B1); PG8_BAR; PG8_SCHED;
            PG8_LDA(At, 1, 1); PG8_STAGE(PG8_SB(1, 0), b3, voffB); PG8_STAGE(PG8_SB(1, 1), b3 + hstep, voffB); PG8_STAGE(PG8_SA(1, 0), a3, v2[0]);
            PG8_WAIT_V(8); PG8_WAIT_L(0); PG8_BAR; PG8_MMA(1, 0, At, B0); PG8_MMA(1, 1, At, B1); PG8_BAR; PG8_SCHED;
        }
        if constexpr (ALIGN_EPI) { if (wr == 0) PG8_BAR; }
        E(acc, cur, wr, wc, fr, fq);
        if (!has_next) break;
#pragma unroll
        for (int a = 0; a < 2; ++a)
#pragma unroll
            for (int b = 0; b < 2; ++b)
#pragma unroll
                for (int m = 0; m < 4; ++m)
#pragma unroll
                    for (int n = 0; n < 2; ++n) acc[a][b][m][n] = (f32x4){0.f, 0.f, 0.f, 0.f};
        cur = nxt; cA = nA; cB = nB; ++ui;
        if constexpr (GA) {
#pragma unroll
            for (int h = 0; h < 2; ++h)
#pragma unroll
                for (int i = 0; i < 2; ++i) vo[h][i] = nvo[h][i];
        }
        if constexpr (ALIGN_EPI) { if (wr == 1) PG8_BAR; }
    }
    PG8_WAIT_V(0);
    if constexpr (!ALIGN_EPI) { if (wr == 0) PG8_BAR; }
    PG8_BAR;
#undef PG8_SA
#undef PG8_SB
#undef PG8_STAGE
#undef PG8_LDA
#undef PG8_LDB
#undef PG8_MMA
#undef PG8_WAIT_V
#undef PG8_WAIT_L
#undef PG8_BAR
#undef PG8_SCHED
}
}
using pg8::Unit;
__device__ __forceinline__ float fast_silu(float v) { return v * __builtin_amdgcn_rcpf(1.0f + __builtin_amdgcn_exp2f(v * -1.4426950408889634f)); }
__device__ __forceinline__ void static_order_unit(int L, int nM, int nN, int& pm, int& pn) {
    const int nwg = nM * nN; int wgid = L; { const int q = nwg / 8, r = nwg % 8, xcd = wgid % 8, off = wgid / 8; wgid = (xcd < r ? xcd * (q + 1) : r * (q + 1) + (xcd - r) * q) + off; }
    const int nig = 8 * nN, gid = wgid / nig, fm = gid * 8, gsz = (nM - fm) < 8 ? (nM - fm) : 8;
    pm = fm + ((wgid % nig) % gsz); pn = (wgid % nig) / gsz;
}
struct SchedIn {
    static constexpr bool GATHER = false;
    const unsigned char* ws; int G, c;
    __device__ __forceinline__ bool next(int i, Unit& u) const {
        const int L = i * G + c; if (L >= 904) return false; u.g = 0;
        if (L >= 896) { const int r = L - 896; u.pm = 64 + (r >> 2); u.pn = 8 + (r & 3); return true; }
        static_order_unit(L, 64, 14, u.pm, u.pn); return true;
    }
    __device__ __forceinline__ const char* a_base(const Unit& u) const { return (const char*)(ws + WS_HX) + (size_t)u.pm * 256 * D * 2; }
    __device__ __forceinline__ const char* b_base(const Unit& u) const { return (const char*)(ws + WS_WIN) + (size_t)u.pn * 256 * D * 2; }
};
struct EpiIn {
    static constexpr bool PERM = true;
    unsigned char* ws;
    __device__ __forceinline__ void operator()(const f32x4 (&acc)[2][2][4][2], const Unit& u, int wr, int wc, int fr, int fq) const {
        const int sec = u.pn >> 1, row0 = u.pm * 256 + wr * 64 + fr;
        if (sec == 3 || sec == 4) {
            const int cl = wc * 32 + 8 * fq, head = 2 * (u.pn & 1) + (cl >> 6), d0 = cl & 63;
            const float* ct = (const float*)(ws + WS_ROPE); const float* st = (const float*)(ws + WS_ROPE_SIN);
            half_t* base = (half_t*)(ws + (sec == 3 ? WS_Q : WS_K)) + head * 128 + d0;
            const float scl = sec == 4 ? 0.08838834764831845f : 1.0f;
#pragma unroll
            for (int ai = 0; ai < 2; ++ai)
#pragma unroll
                for (int m = 0; m < 4; ++m) {
                    const int row = row0 + ai * 128 + m * 16, pos = row < M ? CTXL + (row & (SEQ - 1)) : (row - M) & (CTXL - 1);
                    const f32x4 c0 = *(const f32x4*)(ct + pos * 64 + d0), c1 = *(const f32x4*)(ct + pos * 64 + d0 + 4), s0 = *(const f32x4*)(st + pos * 64 + d0), s1 = *(const f32x4*)(st + pos * 64 + d0 + 4);
                    half8 o1, o2;
#pragma unroll
                    for (int q = 0; q < 4; ++q) {
                        const float ta = acc[ai][0][m][0][q], tb = acc[ai][1][m][0][q]; o1[q] = (half_t)((ta * c0[q] - tb * s0[q]) * scl); o2[q] = (half_t)((ta * s0[q] + tb * c0[q]) * scl);
                        const float tc = acc[ai][0][m][1][q], td = acc[ai][1][m][1][q]; o1[4 + q] = (half_t)((tc * c1[q] - td * s1[q]) * scl); o2[4 + q] = (half_t)((tc * s1[q] + td * c1[q]) * scl);
                    }
                    *(half8*)(base + (size_t)row * RW) = o1; *(half8*)(base + (size_t)row * RW + 64) = o2;
                    asm volatile("" ::: "memory");
                }
        } else {
            const size_t off = sec == 0 ? WS_XB : sec == 1 ? WS_XC : sec == 2 ? WS_XX : sec == 5 ? WS_V : WS_G;
            half_t* base = (half_t*)(ws + off) + (u.pn & 1) * 256 + wc * 32 + 8 * fq;
#pragma unroll
            for (int ai = 0; ai < 2; ++ai)
#pragma unroll
                for (int m = 0; m < 4; ++m) {
                    const int row = row0 + ai * 128 + m * 16;
#pragma unroll
                    for (int bj = 0; bj < 2; ++bj) { half8 o;
#pragma unroll
                        for (int q = 0; q < 4; ++q) { o[q] = (half_t)acc[ai][bj][m][0][q]; o[4 + q] = (half_t)acc[ai][bj][m][1][q]; }
                        *(half8*)(base + (size_t)row * CW + bj * 128) = o; }
                }
        }
    }
};
struct SchedOut {
    static constexpr bool GATHER = false;
    const unsigned char* ws; int G, c;
    __device__ __forceinline__ bool next(int i, Unit& u) const { const int L = i * G + c; if (L >= 256) return false; u.g = 0; static_order_unit(L, 64, 4, u.pm, u.pn); return true; }
    __device__ __forceinline__ const char* a_base(const Unit& u) const { return (const char*)(ws + WS_MIXA) + (size_t)u.pm * 256 * D * 2; }
    __device__ __forceinline__ const char* b_base(const Unit& u) const { return (const char*)(ws + WS_WOUT) + (size_t)u.pn * 256 * D * 2; }
};
struct EpiOut {
    static constexpr bool PERM = false;
    float* out;
    __device__ __forceinline__ void operator()(const f32x4 (&acc)[2][2][4][2], const Unit& u, int wr, int wc, int fr, int fq) const {
        const int row0 = u.pm * 256 + wr * 64 + fr, col0 = u.pn * 256 + wc * 32 + 4 * fq;
#pragma unroll
        for (int ai = 0; ai < 2; ++ai)
#pragma unroll
            for (int m = 0; m < 4; ++m) { float* rowp = out + (size_t)(row0 + ai * 128 + m * 16) * D + col0;
#pragma unroll
                for (int bj = 0; bj < 2; ++bj)
#pragma unroll
                    for (int n = 0; n < 2; ++n) *(f32x4*)(rowp + bj * 128 + n * 16) = acc[ai][bj][m][n]; }
    }
};
struct SchedGU {
    static constexpr bool GATHER = true;
    const unsigned char* ws; int G, c;
    __device__ __forceinline__ bool next(int i, Unit& u) const {
        const int L = i * G + c; if (L >= 2048) return false;
        if (G == 256) { const int x = c & 7, l = c >> 3, e = 2 * i + (x >> 2), pm8 = l & 7; u.g = (pm8 >> 2) * NE + e; u.pm = pm8 & 3; u.pn = (x & 3) * 4 + (l >> 3); }
        else { const int e = L >> 7, r = L & 127, pm8 = r & 7; u.g = (pm8 >> 2) * NE + e; u.pm = pm8 & 3; u.pn = r >> 3; }
        return true;
    }
    __device__ __forceinline__ const char* a_base(const Unit& u) const { return (const char*)(ws + WS_HX2); }
    __device__ __forceinline__ const char* b_base(const Unit& u) const { return (const char*)(ws + WS_WGU) + ((size_t)(u.g & 15) * 4096 + (size_t)u.pn * 256) * D * 2; }
    __device__ __forceinline__ void a_voff(const Unit& u, int tid, unsigned (&vo)[2][2]) const {
        const int* idx = (const int*)(ws + WS_IDX) + u.g * CAP + u.pm * 256; const int b = u.g >> 4;
#pragma unroll
        for (int i = 0; i < 2; ++i) { int R, C; pg8::stage_rc(tid * 16 + i * 8192, R, C);
#pragma unroll
            for (int h = 0; h < 2; ++h) vo[h][i] = (unsigned)((b * SEQ + idx[h * 128 + R]) * D + C) * 2u; }
    }
};
struct EpiGU {
    static constexpr bool PERM = true;
    unsigned char* ws;
    __device__ __forceinline__ void operator()(const f32x4 (&acc)[2][2][4][2], const Unit& u, int wr, int wc, int fr, int fq) const {
        half_t* base = (half_t*)(ws + WS_H) + ((size_t)u.g * CAP + u.pm * 256 + wr * 64 + fr) * DE + u.pn * 128 + wc * 32 + 8 * fq;
#pragma unroll
        for (int ai = 0; ai < 2; ++ai)
#pragma unroll
            for (int m = 0; m < 4; ++m) { half8 o;
#pragma unroll
                for (int q = 0; q < 4; ++q) { o[q] = (half_t)(fast_silu(acc[ai][0][m][0][q]) * acc[ai][1][m][0][q]); o[4 + q] = (half_t)(fast_silu(acc[ai][0][m][1][q]) * acc[ai][1][m][1][q]); }
                *(half8*)(base + (size_t)(ai * 128 + m * 16) * DE) = o; }
    }
};
struct SchedDown {
    static constexpr bool GATHER = false;
    const unsigned char* ws; int G, c;
    __device__ __forceinline__ bool next(int i, Unit& u) const {
        const int L = i * G + c; if (L >= 512) return false;
        if (G == 256) { const int x = c & 7, l = c >> 3, e = 8 * i + x, pm8 = l & 7; u.g = (pm8 >> 2) * NE + e; u.pm = pm8 & 3; u.pn = l >> 3; }
        else { const int e = L >> 5, r = L & 31, pm8 = r & 7; u.g = (pm8 >> 2) * NE + e; u.pm = pm8 & 3; u.pn = r >> 3; }
        return true;
    }
    __device__ __forceinline__ const char* a_base(const Unit& u) const { return (const char*)(ws + WS_H) + ((size_t)u.g * CAP + (size_t)u.pm * 256) * DE * 2; }
    __device__ __forceinline__ const char* b_base(const Unit& u) const { return (const char*)(ws + WS_WD) + ((size_t)(u.g & 15) * D + (size_t)u.pn * 256) * DE * 2; }
};
struct EpiDown {
    static constexpr bool PERM = true;
    unsigned char* ws;
    __device__ __forceinline__ void operator()(const f32x4 (&acc)[2][2][4][2], const Unit& u, int wr, int wc, int fr, int fq) const {
        const int slot0 = u.pm * 256 + wr * 64 + fr;
        const float* gate = (const float*)(ws + WS_GATE) + u.g * CAP;
        half_t* base = (half_t*)(ws + WS_Y) + ((size_t)u.g * CAP + slot0) * D + u.pn * 256 + wc * 32 + 8 * fq;
#pragma unroll
        for (int ai = 0; ai < 2; ++ai)
#pragma unroll
            for (int m = 0; m < 4; ++m) { const float gt = gate[slot0 + ai * 128 + m * 16];
#pragma unroll
                for (int bj = 0; bj < 2; ++bj) { half8 o;
#pragma unroll
                    for (int q = 0; q < 4; ++q) { o[q] = (half_t)(acc[ai][bj][m][0][q] * gt); o[4 + q] = (half_t)(acc[ai][bj][m][1][q] * gt); }
                    *(half8*)(base + (size_t)(ai * 128 + m * 16) * D + bj * 128) = o; } }
    }
};
__device__ __forceinline__ unsigned off_b(unsigned row, unsigned ch) { return 256u * row + 16u * (ch ^ (((row & 3u) << 2) | ((row >> 2) & 3u))); }
__device__ __forceinline__ half8 cat4(half4 a, half4 b) { return __builtin_shufflevector(a, b, 0, 1, 2, 3, 4, 5, 6, 7); }
#define TR8(o, a, b) asm volatile("ds_read_b64_tr_b16 %0, %8\n\tds_read_b64_tr_b16 %1, %8 offset:8192\n\tds_read_b64_tr_b16 %2, %8 offset:16384\n\tds_read_b64_tr_b16 %3, %8 offset:24576\n\t" \
    "ds_read_b64_tr_b16 %4, %9\n\tds_read_b64_tr_b16 %5, %9 offset:8192\n\tds_read_b64_tr_b16 %6, %9 offset:16384\n\tds_read_b64_tr_b16 %7, %9 offset:24576\n\t" \
    "s_waitcnt lgkmcnt(0)" : "=&v"(o[0]), "=&v"(o[1]), "=&v"(o[2]), "=&v"(o[3]), "=&v"(o[4]), "=&v"(o[5]), "=&v"(o[6]), "=&v"(o[7]) : "v"(a), "v"(b) : "memory")
struct TrLane { unsigned rowpart[2], X[2], pb, p8; };
__device__ __forceinline__ TrLane tr_lane(int lane) { TrLane t; const unsigned g = lane >> 4, q = (lane & 15) >> 2, p = lane & 3;
    for (unsigned tt = 0; tt < 2; ++tt) { t.rowpart[tt] = 256u * (8u * g + 4u * tt + q); t.X[tt] = (q << 2) | ((2u * g + tt) & 3u); } t.pb = p >> 1; t.p8 = 8u * (p & 1u); return t; }
__device__ __forceinline__ unsigned tr_addr(const TrLane& t, unsigned tile_base, unsigned c, int tt) { return tile_base + t.rowpart[tt] + 16u * ((2u * c + t.pb) ^ t.X[tt]) + t.p8; }
constexpr float LOG2E = 1.4426950408889634f;
__device__ __forceinline__ int chunk_row0(int b, int ch) { return ch < 2 ? M + b * CTXL + ch * 128 : b * SEQ + (ch - 2) * 128; }
__device__ void ph_r1(const P& p, int wg, int nwg, unsigned char* lds) {
    unsigned char* Kf = lds; unsigned char* Kb = lds + 32768; unsigned char* Vt = lds + 65536;
    const unsigned ldsbase = (unsigned)(size_t)lds;
    const half_t* Kg = (const half_t*)(p.ws + WS_K); const half_t* Vg = (const half_t*)(p.ws + WS_V); half_t* US = (half_t*)(p.ws + WS_US);
    const int wv = threadIdx.x >> 6;
    for (int it = wg; it < 8 * NCHK; it += nwg) {
        int lane = threadIdx.x & 63; asm volatile("" : "+v"(lane));
        const int tid = wv * 64 + lane, fr = lane & 15, fq = lane >> 4; const TrLane tl = tr_lane(lane);
        const int bh = it / NCHK, ch = it % NCHK, b = bh >> 2, h = bh & 3, row0 = chunk_row0(b, ch);
        const float lgf2 = log_sigmoid_f(p.decay[h]) * LOG2E, lgb2 = log_sigmoid_f(p.decay[4 + h]) * LOG2E;
        __syncthreads();
#pragma unroll
        for (int i = 0; i < 4; ++i) { const int n = tid + 512 * i, r = n >> 4, cn = n & 15;
            const half8 kv = *(const half8*)(Kg + (size_t)(row0 + r) * RW + h * 128 + cn * 8), vv = *(const half8*)(Vg + (size_t)(row0 + r) * RW + h * 128 + cn * 8);
            const float zf = __builtin_amdgcn_exp2f(lgf2 * (float)(127 - r)), zb = __builtin_amdgcn_exp2f(lgb2 * (float)r);
            half8 kf, kb;
#pragma unroll
            for (int q = 0; q < 8; ++q) { kf[q] = (half_t)((float)kv[q] * zf); kb[q] = (half_t)((float)kv[q] * zb); }
            const unsigned o = off_b(r, cn);
            *(half8*)(Kf + o) = kf; *(half8*)(Kb + o) = kb; *(half8*)(Vt + o) = vv; }
        __syncthreads();
        half4 o[8]; half8 Xf[4], Xb[4];
        TR8(o, tr_addr(tl, ldsbase, wv, 0), tr_addr(tl, ldsbase, wv, 1));
#pragma unroll
        for (int ks = 0; ks < 4; ++ks) Xf[ks] = cat4(o[ks], o[4 + ks]);
        TR8(o, tr_addr(tl, ldsbase + 32768u, wv, 0), tr_addr(tl, ldsbase + 32768u, wv, 1));
#pragma unroll
        for (int ks = 0; ks < 4; ++ks) Xb[ks] = cat4(o[ks], o[4 + ks]);
        half_t* dstf = US + ((size_t)(bh * NCHK + ch) * 2) * 16384 + (16 * wv + fr) * 128 + 4 * fq; half_t* dstb = dstf + 16384;
#pragma unroll
        for (int et = 0; et < 8; ++et) {
            TR8(o, tr_addr(tl, ldsbase + 65536u, et, 0), tr_addr(tl, ldsbase + 65536u, et, 1));
            f32x4 uf = (f32x4){0.f, 0.f, 0.f, 0.f}, ub = (f32x4){0.f, 0.f, 0.f, 0.f};
#pragma unroll
            for (int ks = 0; ks < 4; ++ks) { const half8 w = cat4(o[ks], o[4 + ks]); uf = __builtin_amdgcn_mfma_f32_16x16x32_f16(w, Xf[ks], uf, 0, 0, 0); ub = __builtin_amdgcn_mfma_f32_16x16x32_f16(w, Xb[ks], ub, 0, 0, 0); }
            half4 hf, hb;
#pragma unroll
            for (int r = 0; r < 4; ++r) { hf[r] = (half_t)uf[r]; hb[r] = (half_t)ub[r]; }
            *(half4*)(dstf + 16 * et) = hf; *(half4*)(dstb + 16 * et) = hb;
        }
    }
}
__device__ void ph_scan(const P& p, int wg, int nwg) {
    const half_t* US = (const half_t*)(p.ws + WS_US); half_t* SH = (half_t*)(p.ws + WS_SH);
    for (int i = wg * blockDim.x + threadIdx.x; i < 8 * 2 * 4096; i += nwg * blockDim.x) {
        const int el = (i & 4095) * 4, dir = (i >> 12) & 1, bh = i >> 13, h = bh & 3;
        const float g128 = expf(log_sigmoid_f(p.decay[dir * 4 + h]) * 128.0f);
        f32x4 S = (f32x4){0.f, 0.f, 0.f, 0.f};
        for (int s = 0; s < NCHK; ++s) {
            const int ch = dir == 0 ? s : (s == 0 ? 1 : (s == 1 ? 0 : 67 - s));
            const size_t o = ((size_t)(bh * NCHK + ch) * 2 + dir) * 16384 + el;
            const half4 uh = *(const half4*)(US + o); const f32x4 u = (f32x4){(float)uh[0], (float)uh[1], (float)uh[2], (float)uh[3]};
            half4 sh; sh[0] = (half_t)S[0]; sh[1] = (half_t)S[1]; sh[2] = (half_t)S[2]; sh[3] = (half_t)S[3];
            *(half4*)(SH + o) = sh; S = S * g128 + u;
        }
    }
}
__device__ void ph_r3(const P& p, int wg, int nwg, unsigned char* lds) {
    const int wv = threadIdx.x >> 6;
    unsigned char* Kt = lds; unsigned char* Vt = lds + 32768; unsigned char* St = lds + 65536; unsigned char* Pw = lds + 98304 + wv * 4096;
    const unsigned ldsbase = (unsigned)(size_t)lds;
    const half_t* Qg = (const half_t*)(p.ws + WS_Q); const half_t* Kg = (const half_t*)(p.ws + WS_K); const half_t* Vg = (const half_t*)(p.ws + WS_V); const half_t* Gg = (const half_t*)(p.ws + WS_G);
    const half_t* SH = (const half_t*)(p.ws + WS_SH); half_t* MIXA = (half_t*)(p.ws + WS_MIXA);
    for (int it = wg; it < 8 * 64; it += nwg) {
        int lane = threadIdx.x & 63; asm volatile("" : "+v"(lane));
        const int tid = wv * 64 + lane, fr = lane & 15, fq = lane >> 4; const TrLane tl = tr_lane(lane);
        const int bh = it >> 6, c = it & 63, b = bh >> 2, h = bh & 3, row0 = b * SEQ + c * 128, ch = c + 2, irow = 16 * wv + fr;
        const float lgf2 = log_sigmoid_f(p.decay[h]) * LOG2E, lgb2 = log_sigmoid_f(p.decay[4 + h]) * LOG2E;
        const half_t* Sfg = SH + ((size_t)(bh * NCHK + ch) * 2) * 16384; const half_t* Sbg = Sfg + 16384;
        __syncthreads();
        half8 qf[4];
#pragma unroll
        for (int ks = 0; ks < 4; ++ks) qf[ks] = *(const half8*)(Qg + (size_t)(row0 + irow) * RW + h * 128 + 32 * ks + 8 * fq);
#pragma unroll
        for (int i = 0; i < 4; ++i) { const int n = tid + 512 * i, r = n >> 4, cn = n & 15; const unsigned o = off_b(r, cn);
            *(half8*)(Kt + o) = *(const half8*)(Kg + (size_t)(row0 + r) * RW + h * 128 + cn * 8);
            *(half8*)(Vt + o) = *(const half8*)(Vg + (size_t)(row0 + r) * RW + h * 128 + cn * 8);
            *(half8*)(St + o) = *(const half8*)(Sfg + r * 128 + cn * 8); }
        __syncthreads();
        half8 sbv[4];
#pragma unroll
        for (int i = 0; i < 4; ++i) { const int n = tid + 512 * i; sbv[i] = *(const half8*)(Sbg + (n >> 4) * 128 + (n & 15) * 8); }
        const float xf = __builtin_amdgcn_exp2f(lgf2 * (float)(irow + 1)), xb = __builtin_amdgcn_exp2f(lgb2 * (float)(128 - irow));
#pragma unroll
        for (int jt = 0; jt < 8; ++jt) {
            f32x4 acc = (f32x4){0.f, 0.f, 0.f, 0.f};
#pragma unroll
            for (int ks = 0; ks < 4; ++ks) { const half8 kf = *(const half8*)(Kt + off_b(fr, 4 * ks + fq) + 4096 * jt); acc = __builtin_amdgcn_mfma_f32_16x16x32_f16(kf, qf[ks], acc, 0, 0, 0); }
            half4 ph;
#pragma unroll
            for (int r = 0; r < 4; ++r) { const int dd = irow - (16 * jt + 4 * fq + r); const float m = dd >= 0 ? __builtin_amdgcn_exp2f(lgf2 * (float)dd) : __builtin_amdgcn_exp2f(lgb2 * (float)(-dd)); ph[r] = (half_t)(acc[r] * m); }
            *(half4*)(Pw + off_b(fr, 2 * jt + (fq >> 1)) + 8 * (fq & 1)) = ph;
        }
        f32x4 Y[8]; half4 o[8];
#pragma unroll
        for (int et = 0; et < 8; ++et) {
            TR8(o, tr_addr(tl, ldsbase + 65536u, et, 0), tr_addr(tl, ldsbase + 65536u, et, 1));
            f32x4 acc = (f32x4){0.f, 0.f, 0.f, 0.f};
#pragma unroll
            for (int ks = 0; ks < 4; ++ks) acc = __builtin_amdgcn_mfma_f32_16x16x32_f16(cat4(o[ks], o[4 + ks]), qf[ks], acc, 0, 0, 0);
            Y[et] = acc * xf;
        }
        __syncthreads();
#pragma unroll
        for (int i = 0; i < 4; ++i) { const int n = tid + 512 * i; *(half8*)(Kt + off_b(n >> 4, n & 15)) = sbv[i]; }
        __syncthreads();
        half8 pf[4];
#pragma unroll
        for (int ks = 0; ks < 4; ++ks) pf[ks] = *(const half8*)(Pw + off_b(fr, 4 * ks + fq));
#pragma unroll
        for (int et = 0; et < 8; ++et) {
            TR8(o, tr_addr(tl, ldsbase + 32768u, et, 0), tr_addr(tl, ldsbase + 32768u, et, 1));
#pragma unroll
            for (int ks = 0; ks < 4; ++ks) Y[et] = __builtin_amdgcn_mfma_f32_16x16x32_f16(cat4(o[ks], o[4 + ks]), pf[ks], Y[et], 0, 0, 0);
            TR8(o, tr_addr(tl, ldsbase, et, 0), tr_addr(tl, ldsbase, et, 1));
            f32x4 acc = (f32x4){0.f, 0.f, 0.f, 0.f};
#pragma unroll
            for (int ks = 0; ks < 4; ++ks) acc = __builtin_amdgcn_mfma_f32_16x16x32_f16(cat4(o[ks], o[4 + ks]), qf[ks], acc, 0, 0, 0);
            Y[et] += acc * xb;
        }
        float s = 0.f;
#pragma unroll
        for (int et = 0; et < 8; ++et) s += (Y[et][0] + Y[et][1]) + (Y[et][2] + Y[et][3]);
        s += __shfl_xor(s, 16); s += __shfl_xor(s, 32);
        const float mu = s * (1.0f / 128.0f); float q2 = 0.f;
#pragma unroll
        for (int et = 0; et < 8; ++et) { const f32x4 d4 = Y[et] - mu; q2 += (d4[0] * d4[0] + d4[1] * d4[1]) + (d4[2] * d4[2] + d4[3] * d4[3]); }
        q2 += __shfl_xor(q2, 16); q2 += __shfl_xor(q2, 32);
        const float rstd = 1.0f / sqrtf(q2 * (1.0f / 128.0f) + GN_EPS);
        const half_t* grow = Gg + (size_t)(row0 + irow) * CW + h * 128 + 4 * fq; half_t* orow = MIXA + (size_t)(row0 + irow) * D + CW + h * 128 + 4 * fq; const float* ng = p.ret_norm_g + h * 128 + 4 * fq;
#pragma unroll
        for (int et = 0; et < 8; ++et) { const half4 g4 = *(const half4*)(grow + 16 * et); const f32x4 n4 = *(const f32x4*)(ng + 16 * et); half4 o4;
#pragma unroll
            for (int r = 0; r < 4; ++r) o4[r] = (half_t)(silu_f((float)g4[r]) * ((Y[et][r] - mu) * rstd * n4[r]));
            *(half4*)(orow + 16 * et) = o4; }
    }
}
__device__ void ph_conv(const P& p, int wg, int nwg) {
    const half_t* XB = (const half_t*)(p.ws + WS_XB); const half_t* XC = (const half_t*)(p.ws + WS_XC); const half_t* XX = (const half_t*)(p.ws + WS_XX); half_t* MIXA = (half_t*)(p.ws + WS_MIXA);
    for (int i = wg * blockDim.x + threadIdx.x; i < M * 64; i += nwg * blockDim.x) {
        const int row = i >> 6, ch0 = (i & 63) * 8, n = row & 63;
        const size_t o = (size_t)row * CW + ch0;
        const half8 c1 = *(const half8*)(XC + o), x1 = *(const half8*)(XX + o), bb = *(const half8*)(XB + o);
        half8 c0 = c1, x0 = x1, c2 = c1, x2 = x1;
        if (n != 0) { c0 = *(const half8*)(XC + o - CW); x0 = *(const half8*)(XX + o - CW); }
        if (n != 63) { c2 = *(const half8*)(XC + o + CW); x2 = *(const half8*)(XX + o + CW); }
        half8 r;
#pragma unroll
        for (int q = 0; q < 8; ++q) {
            const float up = n != 0 ? (float)c0[q] * (float)x0[q] : 0.f, u = (float)c1[q] * (float)x1[q], un = n != 63 ? (float)c2[q] * (float)x2[q] : 0.f;
            const float y = up * p.conv_w[ch0 + q] + u * p.conv_w[CW + ch0 + q] + un * p.conv_w[2 * CW + ch0 + q] + p.conv_b[ch0 + q];
            r[q] = (half_t)((float)bb[q] * y);
        }
        *(half8*)(MIXA + (size_t)row * D + ch0) = r;
    }
}
__device__ void ph_postmix(const P& p, int wg, int nwg, float* lds) {
    const int tid = threadIdx.x, nthr = blockDim.x, lane = tid & 63, wv = tid >> 6, nwv = nthr >> 6;
    const float* mod = (const float*)(p.ws + WS_MOD); half_t* HX2 = (half_t*)(p.ws + WS_HX2); float* AFF = (float*)(p.ws + WS_AFF);
    float* wrT = lds;
    __syncthreads();
    for (int i = tid; i < D * NE; i += nthr) wrT[(i & 15) * D + (i >> 4)] = p.w_router[i];
    __syncthreads();
    for (int row = wg * nwv + wv; row < M; row += nwg * nwv) {
        const int b = row / SEQ; const float* mb = mod + b * 6144;
        const float* g1 = mb + 2048; const float* sh2 = mb + 3072; const float* sc2 = mb + 4096;
        f32x4 mx[4], x1[4]; float ss = 0.f;
#pragma unroll
        for (int j = 0; j < 4; ++j) { mx[j] = ((const f32x4*)(p.out + (size_t)row * D))[lane + 64 * j]; x1[j] = ((const f32x4*)(p.x + (size_t)row * D))[lane + 64 * j]; }
#pragma unroll
        for (int j = 0; j < 4; ++j) ss += (mx[j][0] * mx[j][0] + mx[j][1] * mx[j][1]) + (mx[j][2] * mx[j][2] + mx[j][3] * mx[j][3]);
        ss = wave_sum(ss); const float r1 = 1.0f / sqrtf(ss * (1.0f / D) + RMS_EPS);
        float s2 = 0.f;
#pragma unroll
        for (int j = 0; j < 4; ++j) { const int i0 = 4 * lane + 256 * j; const f32x4 pg = *(const f32x4*)(p.post_mix_g + i0), gg = *(const f32x4*)(g1 + i0);
#pragma unroll
            for (int q = 0; q < 4; ++q) { x1[j][q] = x1[j][q] + gg[q] * (mx[j][q] * r1 * pg[q]); s2 += x1[j][q] * x1[j][q]; }
            *(f32x4*)(p.out + (size_t)row * D + i0) = x1[j]; }
        s2 = wave_sum(s2); const float r2 = 1.0f / sqrtf(s2 * (1.0f / D) + RMS_EPS);
#pragma unroll
        for (int j = 0; j < 4; ++j) { const int i0 = 4 * lane + 256 * j; const f32x4 pg = *(const f32x4*)(p.pre_ffn_g + i0), sc = *(const f32x4*)(sc2 + i0), sh = *(const f32x4*)(sh2 + i0);
            half4 o;
#pragma unroll
            for (int q = 0; q < 4; ++q) { x1[j][q] = x1[j][q] * r2 * pg[q] * (1.0f + sc[q]) + sh[q]; o[q] = (half_t)x1[j][q]; }
            *(half4*)(HX2 + (size_t)row * D + i0) = o; }
        float lg[16];
#pragma unroll
        for (int e = 0; e < 16; ++e) { float a = 0.f; asm volatile("" ::: "memory");
#pragma unroll
            for (int j = 0; j < 4; ++j) { const f32x4 w = *(const f32x4*)(wrT + e * D + 4 * lane + 256 * j); a += (x1[j][0] * w[0] + x1[j][1] * w[1]) + (x1[j][2] * w[2] + x1[j][3] * w[3]); }
            lg[e] = a; }
        float mxl = -1e30f;
#pragma unroll
        for (int e = 0; e < 16; ++e) { lg[e] = wave_sum(lg[e]) + p.b_router[e]; mxl = fmaxf(mxl, lg[e]); }
        float den = 0.f;
#pragma unroll
        for (int e = 0; e < 16; ++e) { lg[e] = expf(lg[e] - mxl); den += lg[e]; }
        const float inv = 1.0f / den;
        float mine = 0.f;
#pragma unroll
        for (int e = 0; e < 16; ++e) if (lane == e) mine = lg[e] * inv;
        if (lane < 16) AFF[((size_t)b * NE + lane) * SEQ + (row & (SEQ - 1))] = mine;
    }
}
__device__ __forceinline__ int block_sum_i(int v, int* red) {
    __syncthreads();
    const int lane = threadIdx.x & 63, wv = threadIdx.x >> 6, nwv = blockDim.x >> 6;
#pragma unroll
    for (int o = 1; o < 64; o <<= 1) v += __shfl_xor(v, o);
    if (lane == 0) red[wv] = v;
    __syncthreads();
    int s = 0; for (int w = 0; w < nwv; ++w) s += red[w];
    return s;
}
__device__ __forceinline__ int block_exscan_i(int v, int* red) {
    __syncthreads();
    const int lane = threadIdx.x & 63, wv = threadIdx.x >> 6, nwv = blockDim.x >> 6;
    int inc = v;
#pragma unroll
    for (int o = 1; o < 64; o <<= 1) { const int t = __shfl_up(inc, o); if (lane >= o) inc += t; }
    if (lane == 63) red[wv] = inc;
    __syncthreads();
    int base = 0; for (int w = 0; w < nwv; ++w) if (w < wv) base += red[w];
    return base + inc - v;
}
__device__ void ph_topk(const P& p, int wg, int nwg, unsigned* lds) {
    unsigned* vals = lds; LAS int* hist = (LAS int*)(lds + SEQ); int* red = (int*)(lds + SEQ + 256); volatile int* sel = (volatile int*)(lds + SEQ + 256 + 16);
    const unsigned* AFFT = (const unsigned*)(p.ws + WS_AFF); int* IDX = (int*)(p.ws + WS_IDX); float* GATE = (float*)(p.ws + WS_GATE); int* INV = (int*)(p.ws + WS_INV);
    const int tid = threadIdx.x, nthr = blockDim.x, seg = SEQ / nthr, lane = tid & 63;
    for (int it = wg; it < NB * NE; it += nwg) {
        const int b = it / NE, e = it % NE;
        __syncthreads();
        for (int t = tid; t < SEQ; t += nthr) vals[t] = AFFT[(size_t)it * SEQ + t];
        unsigned prefix = 0u; int kth = CAP;
        for (int pass = 0; pass < 4; ++pass) {
            const int shift = 24 - 8 * pass; const unsigned himask = pass == 0 ? 0u : (0xFFFFFFFFu << (shift + 8));
            if (tid < 256) hist[tid] = 0;
            __syncthreads();
            for (int t = tid; t < SEQ; t += nthr) { const unsigned v = vals[t]; if ((v & himask) == prefix) __hip_atomic_fetch_add(hist + ((v >> shift) & 255u), 1, __ATOMIC_RELAXED, __HIP_MEMORY_SCOPE_WORKGROUP); }
            __syncthreads();
            if (tid < 64) {
                const int c0 = hist[255 - 4 * lane], c1 = hist[254 - 4 * lane], c2 = hist[253 - 4 * lane], c3 = hist[252 - 4 * lane], s = c0 + c1 + c2 + c3;
                int inc = s;
#pragma unroll
                for (int o = 1; o < 64; o <<= 1) { const int t = __shfl_up(inc, o); if (lane >= o) inc += t; }
                const unsigned long long m = __ballot(inc >= kth); const int first = m ? (__ffsll((long long)m) - 1) : 63;
                if (lane == first) { int cum = inc - s, d = 255 - 4 * lane;
                    if (cum + c0 < kth) { cum += c0; --d; if (cum + c1 < kth) { cum += c1; --d; if (cum + c2 < kth) { cum += c2; --d; } } }
                    sel[0] = (int)(prefix | ((unsigned)d << shift)); sel[1] = kth - cum; }
            }
            __syncthreads();
            prefix = (unsigned)sel[0]; kth = sel[1];
        }
        const unsigned T = prefix; const int need = kth;
        int ceq = 0;
        for (int t = tid * seg; t < tid * seg + seg; ++t) ceq += vals[t] == T ? 1 : 0;
        const int tie_base = block_exscan_i(ceq, red);
        int nsel = 0, tr = tie_base;
        for (int t = tid * seg; t < tid * seg + seg; ++t) { if (vals[t] > T) ++nsel; else if (vals[t] == T) { if (tr < need) ++nsel; ++tr; } }
        int slot = block_exscan_i(nsel, red); tr = tie_base;
        for (int t = tid * seg; t < tid * seg + seg; ++t) {
            bool s2 = false;
            if (vals[t] > T) s2 = true; else if (vals[t] == T) { s2 = tr < need; ++tr; }
            if (s2) { IDX[it * CAP + slot] = t; GATE[it * CAP + slot] = __uint_as_float(vals[t]); INV[(size_t)(b * SEQ + t) * NE + e] = slot; ++slot; }
            else INV[(size_t)(b * SEQ + t) * NE + e] = -1;
        }
    }
}
__device__ void ph_combine(const P& p, int wg, int nwg) {
    const int lane = threadIdx.x & 63, wv = threadIdx.x >> 6, nwv = blockDim.x >> 6;
    const float* mod = (const float*)(p.ws + WS_MOD); const int* INV = (const int*)(p.ws + WS_INV); const half_t* Y = (const half_t*)(p.ws + WS_Y);
    const half_t* zrow = (const half_t*)(p.ws + WS_CTL + 36864);
    const float pscale = PROBE_K ? 1.0f + *(const float*)(p.ws + WS_CTL + 32768) * PROBE_SCALE : 1.0f;
    for (int row = wg * nwv + wv; row < M; row += nwg * nwv) {
        const int b = row / SEQ; const float* g2 = mod + b * 6144 + 5120;
        const int myslot = lane < 16 ? INV[(size_t)row * NE + lane] : -1;
        f32x4 x1[4];
#pragma unroll
        for (int j = 0; j < 4; ++j) x1[j] = ((const f32x4*)(p.out + (size_t)row * D))[lane + 64 * j];
        unsigned m = (unsigned)__ballot(myslot >= 0);
        f32x4 acc[4];
#pragma unroll
        for (int j = 0; j < 4; ++j) acc[j] = (f32x4){0.f, 0.f, 0.f, 0.f};
        while (m) {
#define NEXTPTR(P) const half_t* P = zrow; if (m) { const int e_ = __builtin_ctz(m); m &= m - 1u; const int slot_ = __builtin_amdgcn_readlane(myslot, e_); P = Y + ((size_t)(b * NE + e_) * CAP + slot_) * D; }
            NEXTPTR(q0) NEXTPTR(q1) NEXTPTR(q2) NEXTPTR(q3)
#undef NEXTPTR
            half4 va[4], vb[4], vc[4], vd[4];
#pragma unroll
            for (int j = 0; j < 4; ++j) { va[j] = *(const half4*)(q0 + 4 * lane + 256 * j); vb[j] = *(const half4*)(q1 + 4 * lane + 256 * j); vc[j] = *(const half4*)(q2 + 4 * lane + 256 * j); vd[j] = *(const half4*)(q3 + 4 * lane + 256 * j); }
#pragma unroll
            for (int j = 0; j < 4; ++j)
#pragma unroll
                for (int q = 0; q < 4; ++q) acc[j][q] += ((float)va[j][q] + (float)vb[j][q]) + ((float)vc[j][q] + (float)vd[j][q]);
        }
        float ss = 0.f;
#pragma unroll
        for (int j = 0; j < 4; ++j) ss += (acc[j][0] * acc[j][0] + acc[j][1] * acc[j][1]) + (acc[j][2] * acc[j][2] + acc[j][3] * acc[j][3]);
        ss = wave_sum(ss); const float r = 1.0f / sqrtf(ss * (1.0f / D) + RMS_EPS);
#pragma unroll
        for (int j = 0; j < 4; ++j) { const int i0 = 4 * lane + 256 * j; const f32x4 pg = *(const f32x4*)(p.post_ffn_g + i0), gg = *(const f32x4*)(g2 + i0);
            f32x4 o;
#pragma unroll
            for (int q = 0; q < 4; ++q) o[q] = (x1[j][q] + gg[q] * (acc[j][q] * r * pg[q])) * pscale;
            *(f32x4*)(p.out + (size_t)row * D + i0) = o; }
    }
}
#define XB_TMO      128
#define XB_XCNT(j)  (256  + 64 * (j))
#define XB_XSUB(j)  (1280 + 64 * (j))
#define XB_XGEN(j)  (2304 + 64 * (j))
#define XB_TOP      3328
#define XB_TOPGEN   3392
#define XCD_BAR_WORDS 3456
#define XB_SPIN_CAP (1u << 18)
__device__ __forceinline__ unsigned xb_ld(unsigned* p)              { return __hip_atomic_load(p, __ATOMIC_RELAXED, __HIP_MEMORY_SCOPE_AGENT); }
__device__ __forceinline__ unsigned xb_add(unsigned* p, unsigned v) { return __hip_atomic_fetch_add(p, v, __ATOMIC_RELAXED, __HIP_MEMORY_SCOPE_AGENT); }
__device__ __forceinline__ unsigned xb_xcc_id() { return (unsigned)__builtin_amdgcn_s_getreg((3 << 11) | 20) & 0xFu; }
#define XB_SPIN(cond, bar) do { unsigned _sp = 0; while (cond) { __builtin_amdgcn_s_sleep(1); \
    if ((++_sp & 255u) == 0u) { if (xb_ld(&(bar)[XB_TMO])) break; if (_sp > XB_SPIN_CAP) { atomicAdd(&(bar)[XB_TMO], 1u); break; } } } } while (0)
struct XcdBarrier { unsigned* bar; unsigned x; volatile LAS unsigned* st; };
__device__ __forceinline__ XcdBarrier xcd_barrier_post(unsigned* bar, volatile LAS unsigned* st) {
    XcdBarrier b; b.bar = bar; b.x = xb_xcc_id(); b.st = st;
    if (threadIdx.x == 0) (void)xb_add(&bar[XB_XCNT(b.x)], 1u);
    return b;
}
__device__ __forceinline__ void xcd_barrier_complete(unsigned* bar, unsigned x, unsigned& nloc, unsigned& nx) {
    const unsigned G = gridDim.x * gridDim.y * gridDim.z;
    unsigned sum, cnt, mine, sp = 0u;
    for (;;) {
        sum = 0u; cnt = 0u; mine = 0u;
#pragma unroll
        for (unsigned j = 0; j < 16; ++j) { const unsigned c = xb_ld(&bar[XB_XCNT(j)]); sum += c; cnt += (c > 0u) ? 1u : 0u; mine = (j == x) ? c : mine; }
        if (sum == G) break;
        __builtin_amdgcn_s_sleep(1);
        if ((++sp & 255u) == 0u) { if (xb_ld(&bar[XB_TMO])) break; if (sp > XB_SPIN_CAP) { atomicAdd(&bar[XB_TMO], 1u); break; } }
    }
    nloc = mine > 0u ? mine : 1u; nx = cnt > 0u ? cnt : 1u;
}
__device__ __forceinline__ void xcd_barrier(const XcdBarrier& b) {
    asm volatile("s_waitcnt vmcnt(0)" ::: "memory");
    __syncthreads();
    if (threadIdx.x == 0) {
        unsigned* bar = b.bar;
        __builtin_amdgcn_s_waitcnt(0);
        unsigned nloc = b.st[0], nx = b.st[1];
        if (nloc == 0u) { xcd_barrier_complete(bar, b.x, nloc, nx); b.st[0] = nloc; b.st[1] = nx; }
        const unsigned old = xb_add(&bar[XB_XSUB(b.x)], 1u);
        const unsigned gen = old / nloc;
        if (old + 1u == (gen + 1u) * nloc) {
            __builtin_amdgcn_fence(__ATOMIC_RELEASE, "agent");
            asm volatile("s_waitcnt vmcnt(0)" ::: "memory");
            const unsigned og = xb_add(&bar[XB_TOP], 1u);
            const unsigned tg = og / nx;
            if (og + 1u == (tg + 1u) * nx) xb_add(&bar[XB_TOPGEN], 1u);
            else XB_SPIN(xb_ld(&bar[XB_TOPGEN]) == tg, bar);
            __builtin_amdgcn_fence(__ATOMIC_ACQUIRE, "agent");
            xb_add(&bar[XB_XGEN(b.x)], 1u);
            asm volatile("s_waitcnt vmcnt(0)" ::: "memory");
        } else {
            XB_SPIN(xb_ld(&bar[XB_XGEN(b.x)]) == gen, bar);
            __builtin_amdgcn_fence(__ATOMIC_ACQUIRE, "agent");
            asm volatile("s_waitcnt vmcnt(0)" ::: "memory");
        }
    }
    __syncthreads();
}
constexpr int LDS_BYTES = 147456;
constexpr int MISC_OFF = LDS_BYTES - 128;
constexpr size_t CTL_ZERO_BYTES = 65536;
#define REP_P0 0
#define REP_HX 0
#define REP_GEMM 0
#define REP_RET 0
#define REP_TOPK 0
#define REPEAT(n) for (int rep_ = 0; rep_ < 1 + (n); ++rep_)
#define STAMP(k) do { if (PROBE_K) { const unsigned now_ = (unsigned)__builtin_amdgcn_s_memrealtime(); if ((k) == PROBE_K - 1) pt0 = now_; if ((k) == PROBE_K) pdt = now_ - pt0; } } while (0)
__global__ void __launch_bounds__(512, 2) mega_fwd(P p) {
    extern __shared__ __attribute__((aligned(16))) unsigned char lds[];
    const int wg = blockIdx.x, nwg = gridDim.x;
    volatile LAS unsigned* MISC = (volatile LAS unsigned*)((LAS unsigned char*)lds + MISC_OFF);
    if (threadIdx.x < 32) MISC[threadIdx.x] = 0u;
    __syncthreads();
    const XcdBarrier bar = xcd_barrier_post((unsigned*)(p.ws + WS_CTL) + 4096, MISC + 8);
    unsigned pt0 = 0u, pdt = 0u; STAMP(0);
    REPEAT(REP_P0) { ph_mod_partial(p, wg, nwg); ph_rope(p, wg, nwg); ph_prep_weights(p, wg, nwg, (float*)lds); }
    xcd_barrier(bar); STAMP(1);
    REPEAT(REP_HX) ph_hx(p, wg, nwg, (float*)lds);
    xcd_barrier(bar); STAMP(2);
    REPEAT(REP_GEMM) { const SchedIn S{p.ws, nwg, wg}; const EpiIn E{p.ws}; pg8::gemm_phase<EpiIn, SchedIn, true>((PG8_LAS unsigned char*)lds, D, S, E); }
    xcd_barrier(bar); STAMP(3);
    REPEAT(REP_RET) { ph_r1(p, wg, nwg, lds); ph_conv(p, wg, nwg); }
    xcd_barrier(bar); STAMP(4);
    REPEAT(REP_RET) ph_scan(p, wg, nwg);
    xcd_barrier(bar); STAMP(5);
    REPEAT(REP_RET) ph_r3(p, wg, nwg, lds);
    xcd_barrier(bar); STAMP(6);
    REPEAT(REP_GEMM) { const SchedOut S{p.ws, nwg, wg}; const EpiOut E{p.out}; pg8::gemm_phase<EpiOut, SchedOut, false>((PG8_LAS unsigned char*)lds, D, S, E); }
    xcd_barrier(bar); STAMP(7);
    ph_postmix(p, wg, nwg, (float*)lds);
    xcd_barrier(bar); STAMP(8);
    REPEAT(REP_TOPK) ph_topk(p, wg, nwg, (unsigned*)lds);
    xcd_barrier(bar); STAMP(9);
    REPEAT(REP_GEMM) { const SchedGU S{p.ws, nwg, wg}; const EpiGU E{p.ws}; pg8::gemm_phase<EpiGU, SchedGU, true>((PG8_LAS unsigned char*)lds, D, S, E); }
    xcd_barrier(bar); STAMP(10);
    REPEAT(REP_GEMM) { const SchedDown S{p.ws, nwg, wg}; const EpiDown E{p.ws}; pg8::gemm_phase<EpiDown, SchedDown, true>((PG8_LAS unsigned char*)lds, DE, S, E); }
    xcd_barrier(bar); STAMP(11);
    if (PROBE_K) { if (wg == 0 && threadIdx.x == 0) *(float*)(p.ws + WS_CTL + 32768) = (float)pdt * 0.01f; xcd_barrier(bar); }
    ph_combine(p, wg, nwg);
}

extern "C" void kernel_launch(void* const* d_in, const int* in_sizes, int n_in, void* d_out, int out_size, void* d_ws, size_t ws_size, hipStream_t stream) {
    static int grid = 0;
    if (grid == 0) {
        if (n_in != 21 || ws_size < WS_END || out_size != M * D) { fprintf(stderr, "kernel_launch: unexpected shapes n_in %d ws %zu out %d\n", n_in, ws_size, out_size); grid = -1; return; }
        int dev = 0, cus = 0, per_cu = 0;
        if (hipGetDevice(&dev) != hipSuccess || hipDeviceGetAttribute(&cus, hipDeviceAttributeMultiprocessorCount, dev) != hipSuccess) { grid = -1; return; }
        if (hipFuncSetAttribute((const void*)mega_fwd, hipFuncAttributeMaxDynamicSharedMemorySize, LDS_BYTES) != hipSuccess) { fprintf(stderr, "kernel_launch: hipFuncSetAttribute failed\n"); grid = -1; return; }
        if (hipOccupancyMaxActiveBlocksPerMultiprocessor(&per_cu, (const void*)mega_fwd, 512, LDS_BYTES) != hipSuccess || per_cu < 1) { fprintf(stderr, "kernel_launch: occupancy query says %d\n", per_cu); (void)hipGetLastError(); per_cu = 1; }
        grid = cus;
    }
    if (grid < 0) return;
    if (hipMemsetAsync((char*)d_ws + WS_CTL, 0, CTL_ZERO_BYTES, stream) != hipSuccess) return;
    P p{};
    const float** f = (const float**)&p;
    for (int i = 0; i < 21; ++i) f[i] = (const float*)d_in[i];
    p.out = (float*)d_out; p.ws = (unsigned char*)d_ws;
    hipLaunchKernelGGL(mega_fwd, dim3(grid), dim3(512), LDS_BYTES, stream, p);
}
```
